# Optimizing an MI355X kernel written in HIP

```python
import jax, jax.numpy as jnp
from jax import lax
import numpy as np

D_MODEL = 1024
BATCH = 4
SEQ = 8192
DEPTH = 1

MIX_WIDTH = D_MODEL
LRU_WIDTH = MIX_WIDTH // 2
LRU_HEADS = 8
LRU_HEAD_DIM = LRU_WIDTH // LRU_HEADS
LRU_CONV = 4
LRU_C = 8.0
HGRN_WIDTH = MIX_WIDTH - LRU_WIDTH
HGRN_HEADS = 4
HGRN_HEAD_DIM = HGRN_WIDTH // HGRN_HEADS
HGRN_CHUNK = 64
IN_WIDTH = 2 * LRU_WIDTH + 4 * HGRN_WIDTH
PEER_HEADS = 8
PEER_N_KEYS = 128
PEER_N_EXPERTS = PEER_N_KEYS * PEER_N_KEYS
PEER_TOPK = 16
PEER_QDIM = 256
PEER_HALF = PEER_QDIM // 2
PEER_TOKEN_BLOCK = 128
DN_ALPHA = (2.0 * DEPTH) ** 0.25
DN_BETA = (8.0 * DEPTH) ** -0.25
EPS = 1e-5

kernel_name = "hybrid_rglru_hgrn2_peer_deepnorm"


def layer_norm(x, g, b):
    xf = x.astype(jnp.float32)
    mu = jnp.mean(xf, axis=-1, keepdims=True)
    var = jnp.mean(jnp.square(xf - mu), axis=-1, keepdims=True)
    y = (xf - mu) * lax.rsqrt(var + EPS)
    return (y * g.astype(jnp.float32) + b.astype(jnp.float32)).astype(x.dtype)


def rms_norm(x, g):
    xf = x.astype(jnp.float32)
    y = xf * lax.rsqrt(jnp.mean(jnp.square(xf), axis=-1, keepdims=True) + EPS)
    return (y * g.astype(jnp.float32)).astype(x.dtype)


def causal_dwconv(x, w, b):
    s = x.shape[1]
    xp = jnp.pad(x, ((0, 0), (LRU_CONV - 1, 0), (0, 0)))
    y = b
    for k in range(LRU_CONV):
        y = y + xp[:, k:k + s, :] * w[k]
    return y


def rglru(x, wa, ba, wx, bx, lam):
    bsz, s, _ = x.shape
    xh = x.reshape(bsz, s, LRU_HEADS, LRU_HEAD_DIM)
    r = jax.nn.sigmoid(jnp.einsum('bshi,hij->bshj', xh, wa) + ba).reshape(bsz, s, LRU_WIDTH)
    i = jax.nn.sigmoid(jnp.einsum('bshi,hij->bshj', xh, wx) + bx).reshape(bsz, s, LRU_WIDTH)
    log_a = -LRU_C * r.astype(jnp.float32) * jax.nn.softplus(-lam.astype(jnp.float32))
    a = jnp.exp(log_a)
    mult = jnp.sqrt(-jnp.expm1(2.0 * log_a))
    u = mult * (i * x).astype(jnp.float32)

    def combine(left, right):
        a1, b1 = left
        a2, b2 = right
        return a1 * a2, a2 * b1 + b2

    _, h = lax.associative_scan(combine, (a, u), axis=1)
    return h.astype(x.dtype)


def hgrn2_chunked(q, logf, k, v):
    bsz, s, nh, d = q.shape
    nc = s // HGRN_CHUNK

    def to_chunks(t):
        return t.reshape(bsz, nc, HGRN_CHUNK, nh, d).transpose(1, 0, 3, 2, 4)

    mask = jnp.tril(jnp.ones((HGRN_CHUNK, HGRN_CHUNK), dtype=bool))[None, None, :, :, None]

    def step(state, inp):
        qc, lfc, kc, vc = inp
        b = jnp.cumsum(lfc, axis=2)
        o_inter = jnp.einsum('bhtd,bhde->bhte', qc * jnp.exp(b), state)
        diff = b[:, :, :, None, :] - b[:, :, None, :, :]
        decay = jnp.where(mask, jnp.exp(jnp.where(mask, diff, 0.0)), 0.0)
        scores = jnp.einsum('bhtd,bhsd,bhtsd->bhts', qc, kc, decay)
        o_intra = jnp.einsum('bhts,bhse->bhte', scores, vc)
        b_last = b[:, :, -1:, :]
        new_state = jnp.exp(b_last[:, :, 0, :])[..., None] * state + jnp.einsum(
            'bhsd,bhse->bhde', kc * jnp.exp(b_last - b), vc)
        return new_state, o_inter + o_intra

    init = jnp.zeros((bsz, nh, d, d), jnp.float32)
    _, o = lax.scan(step, init, (to_chunks(q), to_chunks(logf), to_chunks(k), to_chunks(v)))
    return o.transpose(1, 0, 3, 2, 4).reshape(bsz, s, nh, d)


def peer(x, wq, subkeys, u_tab, v_tab):
    bsz, s, d = x.shape
    t = bsz * s
    xt = x.reshape(t, d)
    q = (xt @ wq).reshape(t, PEER_HEADS, 2, PEER_HALF)
    sc = jnp.einsum('thpc,hpnc->thpn', q, subkeys).astype(jnp.float32)
    s_top, i_top = lax.top_k(sc, PEER_TOPK)
    cand = s_top[:, :, 0, :, None] + s_top[:, :, 1, None, :]
    cand_idx = i_top[:, :, 0, :, None] * PEER_N_KEYS + i_top[:, :, 1, None, :]
    best, pos = lax.top_k(cand.reshape(t, PEER_HEADS, PEER_TOPK * PEER_TOPK), PEER_TOPK)
    idx = jnp.take_along_axis(cand_idx.reshape(t, PEER_HEADS, PEER_TOPK * PEER_TOPK), pos, axis=-1)
    gate = jax.nn.softmax(best, axis=-1)

    nb = t // PEER_TOKEN_BLOCK

    def block(args):
        xb, ib, gb = args
        act = jax.nn.gelu(jnp.einsum('thkd,td->thk', u_tab[ib], xb), approximate=False)
        w = (act.astype(jnp.float32) * gb).astype(x.dtype)
        return jnp.einsum('thk,thkd->td', w, v_tab[ib])

    y = lax.map(block, (xt.reshape(nb, PEER_TOKEN_BLOCK, d),
                        idx.reshape(nb, PEER_TOKEN_BLOCK, PEER_HEADS, PEER_TOPK),
                        gate.reshape(nb, PEER_TOKEN_BLOCK, PEER_HEADS, PEER_TOPK)))
    return y.reshape(bsz, s, d)


def setup_inputs(seed: int = 0) -> dict:
    key = jax.random.key(seed)
    ks = jax.random.split(key, 24)
    f32 = jnp.float32
    nrm = lambda k, shape, scale: jax.random.normal(k, shape, f32) * scale
    u0 = jax.random.uniform(ks[8], (DEPTH, LRU_WIDTH), f32, minval=0.9, maxval=0.999)
    p = u0 ** (1.0 / LRU_C)
    lam = jnp.log(p) - jnp.log1p(-p)
    return {
        "x": nrm(ks[0], (BATCH, SEQ, D_MODEL), 1.0),
        "w_in": nrm(ks[1], (DEPTH, D_MODEL, IN_WIDTH), D_MODEL ** -0.5),
        "conv_w": nrm(ks[2], (DEPTH, LRU_CONV, LRU_WIDTH), LRU_CONV ** -0.5),
        "conv_b": nrm(ks[3], (DEPTH, LRU_WIDTH), 0.01),
        "lru_wa": nrm(ks[4], (DEPTH, LRU_HEADS, LRU_HEAD_DIM, LRU_HEAD_DIM), LRU_HEAD_DIM ** -0.5),
        "lru_ba": nrm(ks[5], (DEPTH, LRU_HEADS, LRU_HEAD_DIM), 0.01),
        "lru_wx": nrm(ks[6], (DEPTH, LRU_HEADS, LRU_HEAD_DIM, LRU_HEAD_DIM), LRU_HEAD_DIM ** -0.5),
        "lru_bx": nrm(ks[7], (DEPTH, LRU_HEADS, LRU_HEAD_DIM), 0.01),
        "lru_lambda": lam,
        "lru_norm_g": 1.0 + nrm(ks[9], (DEPTH, LRU_WIDTH), 0.01),
        "hgrn_lb_logits": nrm(ks[10], (DEPTH + 1, HGRN_WIDTH), 0.5),
        "hgrn_norm_g": 1.0 + nrm(ks[11], (DEPTH, HGRN_HEADS, HGRN_HEAD_DIM), 0.01),
        "w_out": nrm(ks[12], (DEPTH, MIX_WIDTH, D_MODEL), MIX_WIDTH ** -0.5 * DN_BETA),
        "ln1_g": 1.0 + nrm(ks[13], (DEPTH, D_MODEL), 0.01),
        "ln1_b": nrm(ks[14], (DEPTH, D_MODEL), 0.01),
        "peer_wq": nrm(ks[15], (DEPTH, D_MODEL, PEER_HEADS * PEER_QDIM), D_MODEL ** -0.5),
        "peer_subkeys": nrm(ks[16], (DEPTH, PEER_HEADS, 2, PEER_N_KEYS, PEER_HALF), PEER_HALF ** -0.5),
        "peer_u": nrm(ks[17], (DEPTH, PEER_N_EXPERTS, D_MODEL), D_MODEL ** -0.5),
        "peer_v": nrm(ks[18], (DEPTH, PEER_N_EXPERTS, D_MODEL), DN_BETA),
        "ln2_g": 1.0 + nrm(ks[19], (DEPTH, D_MODEL), 0.01),
        "ln2_b": nrm(ks[20], (DEPTH, D_MODEL), 0.01),
    }


def reference(x, w_in, conv_w, conv_b, lru_wa, lru_ba, lru_wx, lru_bx, lru_lambda,
              lru_norm_g, hgrn_lb_logits, hgrn_norm_g, w_out, ln1_g, ln1_b,
              peer_wq, peer_subkeys, peer_u, peer_v, ln2_g, ln2_b):
    bsz, s, _ = x.shape
    lb_all = jnp.cumsum(jax.nn.softmax(hgrn_lb_logits.astype(jnp.float32), axis=0), axis=0)
    for l in range(DEPTH):
        h = x @ w_in[l]
        o0 = 0
        lru_x = h[..., o0:o0 + LRU_WIDTH]; o0 += LRU_WIDTH
        lru_gate = h[..., o0:o0 + LRU_WIDTH]; o0 += LRU_WIDTH
        hq = h[..., o0:o0 + HGRN_WIDTH]; o0 += HGRN_WIDTH
        hf = h[..., o0:o0 + HGRN_WIDTH]; o0 += HGRN_WIDTH
        hv = h[..., o0:o0 + HGRN_WIDTH]; o0 += HGRN_WIDTH
        hg = h[..., o0:o0 + HGRN_WIDTH]

        xc = causal_dwconv(lru_x, conv_w[l], conv_b[l])
        hl = rglru(xc, lru_wa[l], lru_ba[l], lru_wx[l], lru_bx[l], lru_lambda[l])
        lru_out = rms_norm(hl * jax.nn.gelu(lru_gate), lru_norm_g[l])

        lb = lb_all[l]
        fz = hf.astype(jnp.float32)
        logf = jnp.log(lb + (1.0 - lb) * jax.nn.sigmoid(fz))
        kk = (1.0 - lb) * jax.nn.sigmoid(-fz)
        hs = (bsz, s, HGRN_HEADS, HGRN_HEAD_DIM)
        o = hgrn2_chunked(hq.astype(jnp.float32).reshape(hs), logf.reshape(hs),
                          kk.reshape(hs), hv.astype(jnp.float32).reshape(hs)).astype(x.dtype)
        o = rms_norm(o, hgrn_norm_g[l]) * jax.nn.silu(hg.reshape(hs))
        hgrn_out = o.reshape(bsz, s, HGRN_WIDTH)

        mix = jnp.concatenate([lru_out, hgrn_out], axis=-1) @ w_out[l]
        x = layer_norm(DN_ALPHA * x + mix, ln1_g[l], ln1_b[l])

        y = peer(x, peer_wq[l], peer_subkeys[l], peer_u[l], peer_v[l])
        x = layer_norm(DN_ALPHA * x + y, ln2_g[l], ln2_b[l])
    return x
```

```cpp
#include <hip/hip_runtime.h>
#include <hip/hip_bf16.h>
#include <cstdio>
#include <cstdint>

#define T_TOK 32768
#define SEQ 8192
#define NB 4
#define DM 1024
#define INW 3072
#define LRUW 512
#define HGW 512
#define NEXP 16384

typedef unsigned short bf16_t;

__device__ __forceinline__ bf16_t f2bf(float f) {
    unsigned u = __float_as_uint(f);
    unsigned r = u + 0x7fffu + ((u >> 16) & 1u);
    return (bf16_t)(r >> 16);
}
__device__ __forceinline__ float bf2f(bf16_t b) { return __uint_as_float(((unsigned)b) << 16); }
__device__ __forceinline__ float sigmoidf_(float x) { return 1.f / (1.f + __expf(-x)); }
__device__ __forceinline__ float gelu_tanh(float x) {
    float u = 0.7978845608028654f * (x + 0.044715f * x * x * x);
    return 0.5f * x * (1.f + tanhf(u));
}
__device__ __forceinline__ float gelu_erf(float x) { return 0.5f * x * (1.f + erff(x * 0.70710678118654752f)); }

template <bool OUT_BF16>
__global__ void __launch_bounds__(256) gemm_naive(const float* __restrict__ A, const float* __restrict__ B, void* __restrict__ Cv, int M, int N, int K) {
    __shared__ float As[16][64 + 1];
    __shared__ float Bs[16][64 + 1];
    const int tx = threadIdx.x & 15, ty = threadIdx.x >> 4;
    const int m0 = blockIdx.y * 64, n0 = blockIdx.x * 64;
    float acc[4][4];
#pragma unroll
    for (int i = 0; i < 4; i++)
#pragma unroll
        for (int j = 0; j < 4; j++) acc[i][j] = 0.f;
    for (int k0 = 0; k0 < K; k0 += 16) {
#pragma unroll
        for (int i = 0; i < 4; i++) {
            int e = threadIdx.x + i * 256;
            int r = e >> 4, c = e & 15;
            As[c][r] = A[(size_t)(m0 + r) * K + k0 + c];
        }
#pragma unroll
        for (int i = 0; i < 4; i++) {
            int e = threadIdx.x + i * 256;
            int r = e >> 6, c = e & 63;
            Bs[r][c] = B[(size_t)(k0 + r) * N + n0 + c];
        }
        __syncthreads();
#pragma unroll
        for (int kk = 0; kk < 16; kk++) {
            float a[4], b[4];
#pragma unroll
            for (int i = 0; i < 4; i++) a[i] = As[kk][ty * 4 + i];
#pragma unroll
            for (int j = 0; j < 4; j++) b[j] = Bs[kk][tx * 4 + j];
#pragma unroll
            for (int i = 0; i < 4; i++)
#pragma unroll
                for (int j = 0; j < 4; j++) acc[i][j] += a[i] * b[j];
        }
        __syncthreads();
    }
#pragma unroll
    for (int i = 0; i < 4; i++)
#pragma unroll
        for (int j = 0; j < 4; j++) {
            size_t o = (size_t)(m0 + ty * 4 + i) * N + n0 + tx * 4 + j;
            if (OUT_BF16) ((bf16_t*)Cv)[o] = f2bf(acc[i][j]);
            else ((float*)Cv)[o] = acc[i][j];
        }
}

__global__ void __launch_bounds__(256) lru_conv(const bf16_t* __restrict__ h, const float* __restrict__ cw, const float* __restrict__ cb, float* __restrict__ xc) {
    size_t i = (size_t)blockIdx.x * 256 + threadIdx.x;
    int c = (int)(i & 511);
    int t = (int)(i >> 9);
    int s = t & (SEQ - 1);
    float y = cb[c];
#pragma unroll
    for (int k = 0; k < 4; k++) {
        int ss = s - 3 + k;
        if (ss >= 0) y += cw[k * 512 + c] * bf2f(h[(size_t)(t - 3 + k) * INW + c]);
    }
    xc[i] = y;
}
__global__ void __launch_bounds__(256) lru_gates(const float* __restrict__ xc, const float* __restrict__ wa, const float* __restrict__ ba, const float* __restrict__ wx,
                                                 const float* __restrict__ bx, const float* __restrict__ lam, float* __restrict__ a_out, float* __restrict__ u_out) {
    size_t i = (size_t)blockIdx.x * 256 + threadIdx.x;
    int c = (int)(i & 511);
    size_t t = i >> 9;
    int hh = c >> 6, j = c & 63;
    const float* xr = xc + t * 512 + hh * 64;
    float sa = ba[c], sx = bx[c];
    for (int k = 0; k < 64; k++) {
        float xv = xr[k];
        sa += xv * wa[(hh * 64 + k) * 64 + j];
        sx += xv * wx[(hh * 64 + k) * 64 + j];
    }
    float r = sigmoidf_(sa), ig = sigmoidf_(sx);
    float sp = log1pf(expf(-lam[c]));
    float log_a = -8.f * r * sp;
    float a = expf(log_a);
    float mult = sqrtf(-expm1f(2.f * log_a));
    a_out[i] = a;
    u_out[i] = mult * (ig * xr[j]);
}
__global__ void __launch_bounds__(256) lru_scan(const float* __restrict__ a, float* __restrict__ u) {
    int i = blockIdx.x * 256 + threadIdx.x;
    int b = i >> 9, c = i & 511;
    float hst = 0.f;
    size_t base = (size_t)b * SEQ * 512 + c;
    for (int s = 0; s < SEQ; s++) {
        size_t o = base + (size_t)s * 512;
        hst = a[o] * hst + u[o];
        u[o] = hst;
    }
}
__global__ void __launch_bounds__(256) lru_out(const float* __restrict__ hl, const bf16_t* __restrict__ h, const float* __restrict__ g, float* __restrict__ mixin) {
    __shared__ float red[4];
    size_t t = blockIdx.x;
    float v[2];
    float ss = 0.f;
#pragma unroll
    for (int k = 0; k < 2; k++) {
        int c = threadIdx.x + k * 256;
        float gate = bf2f(h[t * INW + 512 + c]);
        v[k] = hl[t * 512 + c] * gelu_tanh(gate);
        ss += v[k] * v[k];
    }
    for (int o = 32; o > 0; o >>= 1) ss += __shfl_xor(ss, o);
    if ((threadIdx.x & 63) == 0) red[threadIdx.x >> 6] = ss;
    __syncthreads();
    float tot = red[0] + red[1] + red[2] + red[3];
    float sc = rsqrtf(tot * (1.f / 512.f) + 1e-5f);
#pragma unroll
    for (int k = 0; k < 2; k++) {
        int c = threadIdx.x + k * 256;
        mixin[t * DM + c] = v[k] * sc * g[c];
    }
}

__global__ void __launch_bounds__(128) hgrn_naive(const bf16_t* __restrict__ h, const float* __restrict__ lbl, const float* __restrict__ ng, float* __restrict__ mixin) {
    __shared__ float sq[128], sf[128], sk[128];
    __shared__ float red[2];
    const int b = blockIdx.x >> 2, hh = blockIdx.x & 3;
    const int e = threadIdx.x;
    const int c = hh * 128 + e;
    const float lb = 1.f / (1.f + expf(lbl[512 + c] - lbl[c]));
    const float gn = ng[c];
    float S[128];
#pragma unroll
    for (int d = 0; d < 128; d++) S[d] = 0.f;
    for (int s = 0; s < SEQ; s++) {
        size_t t = (size_t)b * SEQ + s;
        const bf16_t* hr = h + t * INW;
        float qv = bf2f(hr[1024 + c]);
        float fz = bf2f(hr[1536 + c]);
        float vv = bf2f(hr[2048 + c]);
        float gv = bf2f(hr[2560 + c]);
        float sg = sigmoidf_(fz);
        __syncthreads();
        sq[e] = qv;
        sf[e] = lb + (1.f - lb) * sg;
        sk[e] = (1.f - lb) * (1.f - sg);
        __syncthreads();
        float o = 0.f;
#pragma unroll
        for (int d = 0; d < 128; d++) {
            S[d] = sf[d] * S[d] + sk[d] * vv;
            o += S[d] * sq[d];
        }
        float ss = o * o;
        for (int off = 32; off > 0; off >>= 1) ss += __shfl_xor(ss, off);
        if ((e & 63) == 0) red[e >> 6] = ss;
        __syncthreads();
        float tot = red[0] + red[1];
        float y = o * rsqrtf(tot * (1.f / 128.f) + 1e-5f) * gn;
        y *= gv * sigmoidf_(gv);
        mixin[t * DM + 512 + c] = y;
    }
}

__global__ void __launch_bounds__(256) ln_res(const float* __restrict__ x, const float* __restrict__ m, const float* __restrict__ g, const float* __restrict__ bb, float* __restrict__ out) {
    __shared__ float red[8];
    size_t t = blockIdx.x;
    const float alpha = 1.189207115002721f;
    float v[4];
    float s = 0.f;
#pragma unroll
    for (int k = 0; k < 4; k++) {
        int c = threadIdx.x + k * 256;
        v[k] = alpha * x[t * DM + c] + m[t * DM + c];
        s += v[k];
    }
    for (int o = 32; o > 0; o >>= 1) s += __shfl_xor(s, o);
    if ((threadIdx.x & 63) == 0) red[threadIdx.x >> 6] = s;
    __syncthreads();
    float mu = (red[0] + red[1] + red[2] + red[3]) * (1.f / 1024.f);
    float q = 0.f;
#pragma unroll
    for (int k = 0; k < 4; k++) { float d = v[k] - mu; q += d * d; }
    for (int o = 32; o > 0; o >>= 1) q += __shfl_xor(q, o);
    if ((threadIdx.x & 63) == 0) red[4 + (threadIdx.x >> 6)] = q;
    __syncthreads();
    float var = (red[4] + red[5] + red[6] + red[7]) * (1.f / 1024.f);
    float rs = rsqrtf(var + 1e-5f);
#pragma unroll
    for (int k = 0; k < 4; k++) {
        int c = threadIdx.x + k * 256;
        out[t * DM + c] = (v[k] - mu) * rs * g[c] + bb[c];
    }
}

__global__ void __launch_bounds__(256) peer_topk1(const float* __restrict__ q, const float* __restrict__ sk, float* __restrict__ s_top, int* __restrict__ i_top) {
    size_t i = (size_t)blockIdx.x * 256 + threadIdx.x;
    int hp = (int)(i & 15);
    size_t t = i >> 4;
    const float* qr = q + t * 2048 + hp * 128;
    const float* kr = sk + (size_t)hp * 128 * 128;
    float ts[16]; int ti[16];
#pragma unroll
    for (int j = 0; j < 16; j++) { ts[j] = -3.0e38f; ti[j] = 0; }
    for (int n = 0; n < 128; n++) {
        float s = 0.f;
        for (int c = 0; c < 128; c++) s += qr[c] * kr[n * 128 + c];
        float cv = s; int ci = n;
#pragma unroll
        for (int j = 0; j < 16; j++) {
            bool gt = cv > ts[j];
            float tv = gt ? ts[j] : cv; int tix = gt ? ti[j] : ci;
            ts[j] = gt ? cv : ts[j]; ti[j] = gt ? ci : ti[j];
            cv = tv; ci = tix;
        }
    }
#pragma unroll
    for (int j = 0; j < 16; j++) { s_top[i * 16 + j] = ts[j]; i_top[i * 16 + j] = ti[j]; }
}
__global__ void __launch_bounds__(256) peer_topk2(const float* __restrict__ s_top, const int* __restrict__ i_top, int* __restrict__ idx, float* __restrict__ gate) {
    size_t i = (size_t)blockIdx.x * 256 + threadIdx.x;
    const float* s0 = s_top + (i * 2) * 16;
    const float* s1 = s_top + (i * 2 + 1) * 16;
    const int* i0 = i_top + (i * 2) * 16;
    const int* i1 = i_top + (i * 2 + 1) * 16;
    float ts[16]; int ti[16];
#pragma unroll
    for (int j = 0; j < 16; j++) { ts[j] = -3.0e38f; ti[j] = 0; }
    for (int a = 0; a < 16; a++) {
        float sa = s0[a];
        for (int b = 0; b < 16; b++) {
            float cv = sa + s1[b]; int ci = a * 16 + b;
#pragma unroll
            for (int j = 0; j < 16; j++) {
                bool gt = cv > ts[j];
                float tv = gt ? ts[j] : cv; int tix = gt ? ti[j] : ci;
                ts[j] = gt ? cv : ts[j]; ti[j] = gt ? ci : ti[j];
                cv = tv; ci = tix;
            }
        }
    }
    float mx = ts[0];
    float e[16]; float sum = 0.f;
#pragma unroll
    for (int j = 0; j < 16; j++) { e[j] = expf(ts[j] - mx); sum += e[j]; }
    float inv = 1.f / sum;
#pragma unroll
    for (int j = 0; j < 16; j++) {
        int pos = ti[j];
        idx[i * 16 + j] = i0[pos >> 4] * 128 + i1[pos & 15];
        gate[i * 16 + j] = e[j] * inv;
    }
}
__global__ void __launch_bounds__(256) peer_gather(float* __restrict__ x1io, const int* __restrict__ idx, const float* __restrict__ gate, const float* __restrict__ ut, const float* __restrict__ vt,
                                                   const float* __restrict__ g, const float* __restrict__ bb) {
    __shared__ float red[4 * 2];
    __shared__ float red2[8];
    size_t t = blockIdx.x;
    float xv[4], y[4];
#pragma unroll
    for (int k = 0; k < 4; k++) { xv[k] = x1io[t * DM + threadIdx.x + k * 256]; y[k] = 0.f; }
    for (int s = 0; s < 128; s++) {
        int id = idx[t * 128 + s];
        float gt = gate[t * 128 + s];
        const float* ur = ut + (size_t)id * DM;
        const float* vr = vt + (size_t)id * DM;
        float d = 0.f;
#pragma unroll
        for (int k = 0; k < 4; k++) d += ur[threadIdx.x + k * 256] * xv[k];
        for (int o = 32; o > 0; o >>= 1) d += __shfl_xor(d, o);
        int par = s & 1;
        if ((threadIdx.x & 63) == 0) red[par * 4 + (threadIdx.x >> 6)] = d;
        __syncthreads();
        float dot = red[par * 4] + red[par * 4 + 1] + red[par * 4 + 2] + red[par * 4 + 3];
        float w = gelu_erf(dot) * gt;
#pragma unroll
        for (int k = 0; k < 4; k++) y[k] += w * vr[threadIdx.x + k * 256];
    }
    const float alpha = 1.189207115002721f;
    float v[4]; float sm = 0.f;
#pragma unroll
    for (int k = 0; k < 4; k++) { v[k] = alpha * xv[k] + y[k]; sm += v[k]; }
    for (int o = 32; o > 0; o >>= 1) sm += __shfl_xor(sm, o);
    __syncthreads();
    if ((threadIdx.x & 63) == 0) red2[threadIdx.x >> 6] = sm;
    __syncthreads();
    float mu = (red2[0] + red2[1] + red2[2] + red2[3]) * (1.f / 1024.f);
    float q = 0.f;
#pragma unroll
    for (int k = 0; k < 4; k++) { float d = v[k] - mu; q += d * d; }
    for (int o = 32; o > 0; o >>= 1) q += __shfl_xor(q, o);
    if ((threadIdx.x & 63) == 0) red2[4 + (threadIdx.x >> 6)] = q;
    __syncthreads();
    float var = (red2[4] + red2[5] + red2[6] + red2[7]) * (1.f / 1024.f);
    float rs = rsqrtf(var + 1e-5f);
#pragma unroll
    for (int k = 0; k < 4; k++) {
        int c = threadIdx.x + k * 256;
        x1io[t * DM + c] = (v[k] - mu) * rs * g[c] + bb[c];
    }
}

extern "C" void kernel_launch(void* const* d_in, const int* in_sizes, int n_in, void* d_out, int out_size, void* d_ws, size_t ws_size, hipStream_t stream) {
    const float* x = (const float*)d_in[0];
    const float* w_in = (const float*)d_in[1];
    const float* conv_w = (const float*)d_in[2];
    const float* conv_b = (const float*)d_in[3];
    const float* lru_wa = (const float*)d_in[4];
    const float* lru_ba = (const float*)d_in[5];
    const float* lru_wx = (const float*)d_in[6];
    const float* lru_bx = (const float*)d_in[7];
    const float* lru_lam = (const float*)d_in[8];
    const float* lru_ng = (const float*)d_in[9];
    const float* lbl = (const float*)d_in[10];
    const float* hg_ng = (const float*)d_in[11];
    const float* w_out = (const float*)d_in[12];
    const float* ln1_g = (const float*)d_in[13];
    const float* ln1_b = (const float*)d_in[14];
    const float* wq = (const float*)d_in[15];
    const float* subk = (const float*)d_in[16];
    const float* ut = (const float*)d_in[17];
    const float* vt = (const float*)d_in[18];
    const float* ln2_g = (const float*)d_in[19];
    const float* ln2_b = (const float*)d_in[20];
    float* out = (float*)d_out;
    char* ws = (char*)d_ws;
    const size_t MB = 1024 * 1024;
    if (ws_size < 500 * MB) { fprintf(stderr, "ws too small %zu\n", ws_size); return; }
    bf16_t* h = (bf16_t*)(ws);
    float* mix = (float*)(ws);
    float* q = (float*)(ws);
    float* xc = (float*)(ws + 300 * MB);
    float* s_top = (float*)(ws + 300 * MB);
    int* i_top = (int*)(ws + 334 * MB);
    float* mixin = (float*)(ws + 368 * MB);
    int* idx = (int*)(ws + 368 * MB);
    float* gate = (float*)(ws + 384 * MB);
    float* a_arr = out;
    float* u_arr = out + (size_t)T_TOK * 512;

    gemm_naive<true><<<dim3(INW / 64, T_TOK / 64), 256, 0, stream>>>(x, w_in, h, T_TOK, INW, DM);
    lru_conv<<<T_TOK * 512 / 256, 256, 0, stream>>>(h, conv_w, conv_b, xc);
    lru_gates<<<T_TOK * 512 / 256, 256, 0, stream>>>(xc, lru_wa, lru_ba, lru_wx, lru_bx, lru_lam, a_arr, u_arr);
    lru_scan<<<2048 / 256, 256, 0, stream>>>(a_arr, u_arr);
    lru_out<<<T_TOK, 256, 0, stream>>>(u_arr, h, lru_ng, mixin);
    hgrn_naive<<<16, 128, 0, stream>>>(h, lbl, hg_ng, mixin);
    gemm_naive<false><<<dim3(DM / 64, T_TOK / 64), 256, 0, stream>>>(mixin, w_out, mix, T_TOK, DM, DM);
    ln_res<<<T_TOK, 256, 0, stream>>>(x, mix, ln1_g, ln1_b, out);
    gemm_naive<false><<<dim3(2048 / 64, T_TOK / 64), 256, 0, stream>>>(out, wq, q, T_TOK, 2048, DM);
    peer_topk1<<<T_TOK * 16 / 256, 256, 0, stream>>>(q, subk, s_top, i_top);
    peer_topk2<<<T_TOK * 8 / 256, 256, 0, stream>>>(s_top, i_top, idx, gate);
    peer_gather<<<T_TOK, 256, 0, stream>>>(out, idx, gate, ut, vt, ln2_g, ln2_b);
}
```

```cpp
#include <hip/hip_runtime.h>
#include <hip/hip_bf16.h>
#include <hip/hip_cooperative_groups.h>
namespace cg = cooperative_groups;
#include <cstdio>
#include <cstdint>

#define T_TOK 32768
#define SEQ 8192
#define NB 4
#define DM 1024
#define INW 3072
#define LRUW 512
#define HGW 512
#define NEXP 16384

typedef unsigned short bf16_t;

__device__ __forceinline__ bf16_t f2bf(float f) {
    unsigned u = __float_as_uint(f);
    unsigned r = u + 0x7fffu + ((u >> 16) & 1u);
    return (bf16_t)(r >> 16);
}
__device__ __forceinline__ float bf2f(bf16_t b) { return __uint_as_float(((unsigned)b) << 16); }
__device__ __forceinline__ float sigmoidf_(float x) { return 1.f / (1.f + __expf(-x)); }
__device__ __forceinline__ float gelu_tanh(float x) {
    float u = 0.7978845608028654f * (x + 0.044715f * x * x * x);
    return 0.5f * x * (1.f + tanhf(u));
}
__device__ __forceinline__ float gelu_erf(float x) { return 0.5f * x * (1.f + erff(x * 0.70710678118654752f)); }

template <bool OUT_BF16>
__device__ void gemm_naive(int unit, const float* __restrict__ A, const float* __restrict__ B, void* __restrict__ Cv, int M, int N, int K) {
    __shared__ float As[16][64 + 1];
    __shared__ float Bs[16][64 + 1];
    const int tx = threadIdx.x & 15, ty = threadIdx.x >> 4;
    const int nbx = N / 64;
    const int m0 = (unit / nbx) * 64, n0 = (unit % nbx) * 64;
    __syncthreads();
    float acc[4][4];
#pragma unroll
    for (int i = 0; i < 4; i++)
#pragma unroll
        for (int j = 0; j < 4; j++) acc[i][j] = 0.f;
    for (int k0 = 0; k0 < K; k0 += 16) {
#pragma unroll
        for (int i = 0; i < 4; i++) {
            int e = threadIdx.x + i * 256;
            int r = e >> 4, c = e & 15;
            As[c][r] = A[(size_t)(m0 + r) * K + k0 + c];
        }
#pragma unroll
        for (int i = 0; i < 4; i++) {
            int e = threadIdx.x + i * 256;
            int r = e >> 6, c = e & 63;
            Bs[r][c] = B[(size_t)(k0 + r) * N + n0 + c];
        }
        __syncthreads();
#pragma unroll
        for (int kk = 0; kk < 16; kk++) {
            float a[4], b[4];
#pragma unroll
            for (int i = 0; i < 4; i++) a[i] = As[kk][ty * 4 + i];
#pragma unroll
            for (int j = 0; j < 4; j++) b[j] = Bs[kk][tx * 4 + j];
#pragma unroll
            for (int i = 0; i < 4; i++)
#pragma unroll
                for (int j = 0; j < 4; j++) acc[i][j] += a[i] * b[j];
        }
        __syncthreads();
    }
#pragma unroll
    for (int i = 0; i < 4; i++)
#pragma unroll
        for (int j = 0; j < 4; j++) {
            size_t o = (size_t)(m0 + ty * 4 + i) * N + n0 + tx * 4 + j;
            if (OUT_BF16) ((bf16_t*)Cv)[o] = f2bf(acc[i][j]);
            else ((float*)Cv)[o] = acc[i][j];
        }
}

__device__ void lru_conv(int unit, const bf16_t* __restrict__ h, const float* __restrict__ cw, const float* __restrict__ cb, float* __restrict__ xc) {
    size_t i = (size_t)unit * 256 + threadIdx.x;
    int c = (int)(i & 511);
    int t = (int)(i >> 9);
    int s = t & (SEQ - 1);
    float y = cb[c];
#pragma unroll
    for (int k = 0; k < 4; k++) {
        int ss = s - 3 + k;
        if (ss >= 0) y += cw[k * 512 + c] * bf2f(h[(size_t)(t - 3 + k) * INW + c]);
    }
    xc[i] = y;
}
__device__ void lru_gates(int unit, const float* __restrict__ xc, const float* __restrict__ wa, const float* __restrict__ ba, const float* __restrict__ wx,
                                                 const float* __restrict__ bx, const float* __restrict__ lam, float* __restrict__ a_out, float* __restrict__ u_out) {
    size_t i = (size_t)unit * 256 + threadIdx.x;
    int c = (int)(i & 511);
    size_t t = i >> 9;
    int hh = c >> 6, j = c & 63;
    const float* xr = xc + t * 512 + hh * 64;
    float sa = ba[c], sx = bx[c];
    for (int k = 0; k < 64; k++) {
        float xv = xr[k];
        sa += xv * wa[(hh * 64 + k) * 64 + j];
        sx += xv * wx[(hh * 64 + k) * 64 + j];
    }
    float r = sigmoidf_(sa), ig = sigmoidf_(sx);
    float sp = log1pf(expf(-lam[c]));
    float log_a = -8.f * r * sp;
    float a = expf(log_a);
    float mult = sqrtf(-expm1f(2.f * log_a));
    a_out[i] = a;
    u_out[i] = mult * (ig * xr[j]);
}
__device__ void lru_scan(int unit, const float* __restrict__ a, float* __restrict__ u) {
    int i = unit * 256 + threadIdx.x;
    int b = i >> 9, c = i & 511;
    float hst = 0.f;
    size_t base = (size_t)b * SEQ * 512 + c;
    for (int s = 0; s < SEQ; s++) {
        size_t o = base + (size_t)s * 512;
        hst = a[o] * hst + u[o];
        u[o] = hst;
    }
}
__device__ void lru_out(int unit, const float* __restrict__ hl, const bf16_t* __restrict__ h, const float* __restrict__ g, float* __restrict__ mixin) {
    __shared__ float red[4];
    __syncthreads();
    size_t t = unit;
    float v[2];
    float ss = 0.f;
#pragma unroll
    for (int k = 0; k < 2; k++) {
        int c = threadIdx.x + k * 256;
        float gate = bf2f(h[t * INW + 512 + c]);
        v[k] = hl[t * 512 + c] * gelu_tanh(gate);
        ss += v[k] * v[k];
    }
    for (int o = 32; o > 0; o >>= 1) ss += __shfl_xor(ss, o);
    if ((threadIdx.x & 63) == 0) red[threadIdx.x >> 6] = ss;
    __syncthreads();
    float tot = red[0] + red[1] + red[2] + red[3];
    float sc = rsqrtf(tot * (1.f / 512.f) + 1e-5f);
#pragma unroll
    for (int k = 0; k < 2; k++) {
        int c = threadIdx.x + k * 256;
        mixin[t * DM + c] = v[k] * sc * g[c];
    }
}

__device__ void hgrn_naive(int unit, const bf16_t* __restrict__ h, const float* __restrict__ lbl, const float* __restrict__ ng, float* __restrict__ mixin) {
    __shared__ float sq[2][128], sf[2][128], sk[2][128];
    __shared__ float red[4];
    const int half = threadIdx.x >> 7;
    const int pair = unit * 2 + half;
    const int b = pair >> 2, hh = pair & 3;
    const int e = threadIdx.x & 127;
    const int c = hh * 128 + e;
    const float lb = 1.f / (1.f + expf(lbl[512 + c] - lbl[c]));
    const float gn = ng[c];
    float S[128];
#pragma unroll
    for (int d = 0; d < 128; d++) S[d] = 0.f;
    for (int s = 0; s < SEQ; s++) {
        size_t t = (size_t)b * SEQ + s;
        const bf16_t* hr = h + t * INW;
        float qv = bf2f(hr[1024 + c]);
        float fz = bf2f(hr[1536 + c]);
        float vv = bf2f(hr[2048 + c]);
        float gv = bf2f(hr[2560 + c]);
        float sg = sigmoidf_(fz);
        __syncthreads();
        sq[half][e] = qv;
        sf[half][e] = lb + (1.f - lb) * sg;
        sk[half][e] = (1.f - lb) * (1.f - sg);
        __syncthreads();
        float o = 0.f;
#pragma unroll
        for (int d = 0; d < 128; d++) {
            S[d] = sf[half][d] * S[d] + sk[half][d] * vv;
            o += S[d] * sq[half][d];
        }
        float ss = o * o;
        for (int off = 32; off > 0; off >>= 1) ss += __shfl_xor(ss, off);
        if ((e & 63) == 0) red[threadIdx.x >> 6] = ss;
        __syncthreads();
        float tot = red[half * 2] + red[half * 2 + 1];
        float y = o * rsqrtf(tot * (1.f / 128.f) + 1e-5f) * gn;
        y *= gv * sigmoidf_(gv);
        mixin[t * DM + 512 + c] = y;
    }
}

__device__ void ln_res(int unit, const float* __restrict__ x, const float* __restrict__ m, const float* __restrict__ g, const float* __restrict__ bb, float* __restrict__ out) {
    __shared__ float red[8];
    __syncthreads();
    size_t t = unit;
    const float alpha = 1.189207115002721f;
    float v[4];
    float s = 0.f;
#pragma unroll
    for (int k = 0; k < 4; k++) {
        int c = threadIdx.x + k * 256;
        v[k] = alpha * x[t * DM + c] + m[t * DM + c];
        s += v[k];
    }
    for (int o = 32; o > 0; o >>= 1) s += __shfl_xor(s, o);
    if ((threadIdx.x & 63) == 0) red[threadIdx.x >> 6] = s;
    __syncthreads();
    float mu = (red[0] + red[1] + red[2] + red[3]) * (1.f / 1024.f);
    float q = 0.f;
#pragma unroll
    for (int k = 0; k < 4; k++) { float d = v[k] - mu; q += d * d; }
    for (int o = 32; o > 0; o >>= 1) q += __shfl_xor(q, o);
    if ((threadIdx.x & 63) == 0) red[4 + (threadIdx.x >> 6)] = q;
    __syncthreads();
    float var = (red[4] + red[5] + red[6] + red[7]) * (1.f / 1024.f);
    float rs = rsqrtf(var + 1e-5f);
#pragma unroll
    for (int k = 0; k < 4; k++) {
        int c = threadIdx.x + k * 256;
        out[t * DM + c] = (v[k] - mu) * rs * g[c] + bb[c];
    }
}

__device__ void peer_topk1(int unit, const float* __restrict__ q, const float* __restrict__ sk, float* __restrict__ s_top, int* __restrict__ i_top) {
    size_t i = (size_t)unit * 256 + threadIdx.x;
    int hp = (int)(i & 15);
    size_t t = i >> 4;
    const float* qr = q + t * 2048 + hp * 128;
    const float* kr = sk + (size_t)hp * 128 * 128;
    float ts[16]; int ti[16];
#pragma unroll
    for (int j = 0; j < 16; j++) { ts[j] = -3.0e38f; ti[j] = 0; }
    for (int n = 0; n < 128; n++) {
        float s = 0.f;
        for (int c = 0; c < 128; c++) s += qr[c] * kr[n * 128 + c];
        float cv = s; int ci = n;
#pragma unroll
        for (int j = 0; j < 16; j++) {
            bool gt = cv > ts[j];
            float tv = gt ? ts[j] : cv; int tix = gt ? ti[j] : ci;
            ts[j] = gt ? cv : ts[j]; ti[j] = gt ? ci : ti[j];
            cv = tv; ci = tix;
        }
    }
#pragma unroll
    for (int j = 0; j < 16; j++) { s_top[i * 16 + j] = ts[j]; i_top[i * 16 + j] = ti[j]; }
}
__device__ void peer_topk2(int unit, const float* __restrict__ s_top, const int* __restrict__ i_top, int* __restrict__ idx, float* __restrict__ gate) {
    size_t i = (size_t)unit * 256 + threadIdx.x;
    const float* s0 = s_top + (i * 2) * 16;
    const float* s1 = s_top + (i * 2 + 1) * 16;
    const int* i0 = i_top + (i * 2) * 16;
    const int* i1 = i_top + (i * 2 + 1) * 16;
    float ts[16]; int ti[16];
#pragma unroll
    for (int j = 0; j < 16; j++) { ts[j] = -3.0e38f; ti[j] = 0; }
    for (int a = 0; a < 16; a++) {
        float sa = s0[a];
        for (int b = 0; b < 16; b++) {
            float cv = sa + s1[b]; int ci = a * 16 + b;
#pragma unroll
            for (int j = 0; j < 16; j++) {
                bool gt = cv > ts[j];
                float tv = gt ? ts[j] : cv; int tix = gt ? ti[j] : ci;
                ts[j] = gt ? cv : ts[j]; ti[j] = gt ? ci : ti[j];
                cv = tv; ci = tix;
            }
        }
    }
    float mx = ts[0];
    float e[16]; float sum = 0.f;
#pragma unroll
    for (int j = 0; j < 16; j++) { e[j] = expf(ts[j] - mx); sum += e[j]; }
    float inv = 1.f / sum;
#pragma unroll
    for (int j = 0; j < 16; j++) {
        int pos = ti[j];
        idx[i * 16 + j] = i0[pos >> 4] * 128 + i1[pos & 15];
        gate[i * 16 + j] = e[j] * inv;
    }
}
__device__ void peer_gather(int unit, float* __restrict__ x1io, const int* __restrict__ idx, const float* __restrict__ gate, const float* __restrict__ ut, const float* __restrict__ vt,
                                                   const float* __restrict__ g, const float* __restrict__ bb) {
    __shared__ float red[4 * 2];
    __shared__ float red2[8];
    __syncthreads();
    size_t t = unit;
    float xv[4], y[4];
#pragma unroll
    for (int k = 0; k < 4; k++) { xv[k] = x1io[t * DM + threadIdx.x + k * 256]; y[k] = 0.f; }
    for (int s = 0; s < 128; s++) {
        int id = idx[t * 128 + s];
        float gt = gate[t * 128 + s];
        const float* ur = ut + (size_t)id * DM;
        const float* vr = vt + (size_t)id * DM;
        float d = 0.f;
#pragma unroll
        for (int k = 0; k < 4; k++) d += ur[threadIdx.x + k * 256] * xv[k];
        for (int o = 32; o > 0; o >>= 1) d += __shfl_xor(d, o);
        int par = s & 1;
        if ((threadIdx.x & 63) == 0) red[par * 4 + (threadIdx.x >> 6)] = d;
        __syncthreads();
        float dot = red[par * 4] + red[par * 4 + 1] + red[par * 4 + 2] + red[par * 4 + 3];
        float w = gelu_erf(dot) * gt;
#pragma unroll
        for (int k = 0; k < 4; k++) y[k] += w * vr[threadIdx.x + k * 256];
    }
    const float alpha = 1.189207115002721f;
    float v[4]; float sm = 0.f;
#pragma unroll
    for (int k = 0; k < 4; k++) { v[k] = alpha * xv[k] + y[k]; sm += v[k]; }
    for (int o = 32; o > 0; o >>= 1) sm += __shfl_xor(sm, o);
    __syncthreads();
    if ((threadIdx.x & 63) == 0) red2[threadIdx.x >> 6] = sm;
    __syncthreads();
    float mu = (red2[0] + red2[1] + red2[2] + red2[3]) * (1.f / 1024.f);
    float q = 0.f;
#pragma unroll
    for (int k = 0; k < 4; k++) { float d = v[k] - mu; q += d * d; }
    for (int o = 32; o > 0; o >>= 1) q += __shfl_xor(q, o);
    if ((threadIdx.x & 63) == 0) red2[4 + (threadIdx.x >> 6)] = q;
    __syncthreads();
    float var = (red2[4] + red2[5] + red2[6] + red2[7]) * (1.f / 1024.f);
    float rs = rsqrtf(var + 1e-5f);
#pragma unroll
    for (int k = 0; k < 4; k++) {
        int c = threadIdx.x + k * 256;
        x1io[t * DM + c] = (v[k] - mu) * rs * g[c] + bb[c];
    }
}

struct Params {
    const float* in[21];
    float* out;
    char* ws;
};

__global__ void __launch_bounds__(256) mega(Params p) {
    cg::grid_group grid = cg::this_grid();
    const float* x = p.in[0];
    const float* w_in = p.in[1];
    const float* conv_w = p.in[2];
    const float* conv_b = p.in[3];
    const float* lru_wa = p.in[4];
    const float* lru_ba = p.in[5];
    const float* lru_wx = p.in[6];
    const float* lru_bx = p.in[7];
    const float* lru_lam = p.in[8];
    const float* lru_ng = p.in[9];
    const float* lbl = p.in[10];
    const float* hg_ng = p.in[11];
    const float* w_out = p.in[12];
    const float* ln1_g = p.in[13];
    const float* ln1_b = p.in[14];
    const float* wq = p.in[15];
    const float* subk = p.in[16];
    const float* ut = p.in[17];
    const float* vt = p.in[18];
    const float* ln2_g = p.in[19];
    const float* ln2_b = p.in[20];
    float* out = p.out;
    char* ws = p.ws;
    const size_t MB = 1024 * 1024;
    bf16_t* h = (bf16_t*)(ws);
    float* mix = (float*)(ws);
    float* q = (float*)(ws);
    float* xc = (float*)(ws + 300 * MB);
    float* s_top = (float*)(ws + 300 * MB);
    int* i_top = (int*)(ws + 334 * MB);
    float* mixin = (float*)(ws + 368 * MB);
    int* idx = (int*)(ws + 368 * MB);
    float* gate = (float*)(ws + 384 * MB);
    float* a_arr = out;
    float* u_arr = out + (size_t)T_TOK * 512;
    const int G = gridDim.x, bid = blockIdx.x;

    for (int u = bid; u < (INW / 64) * (T_TOK / 64); u += G) gemm_naive<true>(u, x, w_in, h, T_TOK, INW, DM);
    grid.sync();
    for (int u = bid; u < T_TOK * 512 / 256; u += G) lru_conv(u, h, conv_w, conv_b, xc);
    grid.sync();
    for (int u = bid; u < T_TOK * 512 / 256; u += G) lru_gates(u, xc, lru_wa, lru_ba, lru_wx, lru_bx, lru_lam, a_arr, u_arr);
    grid.sync();
    for (int u = bid; u < 16; u += G) {
        if (u < 8) hgrn_naive(u, h, lbl, hg_ng, mixin);
        else lru_scan(u - 8, a_arr, u_arr);
    }
    grid.sync();
    for (int u = bid; u < T_TOK; u += G) lru_out(u, u_arr, h, lru_ng, mixin);
    grid.sync();
    for (int u = bid; u < (DM / 64) * (T_TOK / 64); u += G) gemm_naive<false>(u, mixin, w_out, mix, T_TOK, DM, DM);
    grid.sync();
    for (int u = bid; u < T_TOK; u += G) ln_res(u, x, mix, ln1_g, ln1_b, out);
    grid.sync();
    for (int u = bid; u < (2048 / 64) * (T_TOK / 64); u += G) gemm_naive<false>(u, out, wq, q, T_TOK, 2048, DM);
    grid.sync();
    for (int u = bid; u < T_TOK * 16 / 256; u += G) peer_topk1(u, q, subk, s_top, i_top);
    grid.sync();
    for (int u = bid; u < T_TOK * 8 / 256; u += G) peer_topk2(u, s_top, i_top, idx, gate);
    grid.sync();
    for (int u = bid; u < T_TOK; u += G) peer_gather(u, out, idx, gate, ut, vt, ln2_g, ln2_b);
}

extern "C" void kernel_launch(void* const* d_in, const int* in_sizes, int n_in, void* d_out, int out_size, void* d_ws, size_t ws_size, hipStream_t stream) {
    static int grid_blocks = 0;
    if (!grid_blocks) {
        int dev = 0, cus = 0, per_cu = 0;
        (void)hipGetDevice(&dev);
        (void)hipDeviceGetAttribute(&cus, hipDeviceAttributeMultiprocessorCount, dev);
        (void)hipOccupancyMaxActiveBlocksPerMultiprocessor(&per_cu, mega, 256, 0);
        if (per_cu > 4) per_cu = 4;
        grid_blocks = cus * per_cu;
        if (grid_blocks <= 0) { fprintf(stderr, "bad occupancy\n"); grid_blocks = 0; return; }
    }
    if (ws_size < 500ull * 1024 * 1024 || n_in != 21) { fprintf(stderr, "ws too small %zu or n_in %d\n", ws_size, n_in); return; }
    Params p{};
    for (int i = 0; i < 21; i++) p.in[i] = (const float*)d_in[i];
    p.out = (float*)d_out;
    p.ws = (char*)d_ws;
    void* args[] = {&p};
    hipError_t e = hipLaunchCooperativeKernel((void*)mega, dim3(grid_blocks), dim3(256), args, 0, stream);
    if (e != hipSuccess) fprintf(stderr, "cooperative launch failed: %s (grid %d)\n", hipGetErrorString(e), grid_blocks);
}
```

```cpp
#include <hip/hip_runtime.h>
#include <hip/hip_cooperative_groups.h>
#include <cstdio>
#include <cstdint>
namespace cg = cooperative_groups;

#ifndef PEER_SLICED
#define PEER_SLICED 1
#endif
#ifndef PROBE_PHASE
#define PROBE_PHASE 0
#endif
#ifndef PROBE_NREP
#define PROBE_NREP 0
#endif
#define T_TOK 32768
#define SEQ 8192
#define DM 1024
#define INW 3072
#define NTHR 512
#define LDS_BYTES (144 * 1024)
#define ALPHA 1.189207115002721f
#define LAS __attribute__((address_space(3)))

namespace pg8 {
#define PG8_LAS __attribute__((address_space(3)))
typedef unsigned short bf16_t;
typedef short bf16x8 __attribute__((ext_vector_type(8)));
typedef float f32x4 __attribute__((ext_vector_type(4)));
typedef unsigned u32x4 __attribute__((ext_vector_type(4)));
constexpr int BM = 256, BK = 64, HALF = 128, HTB = HALF * BK * 2  , STAGE_BYTES = 8 * HTB, NXCD = 8, WGM = 8;

__host__ __device__ __forceinline__ int lds_byte(int r, int c) { const int st = (r >> 4) * 2 + (c >> 5), rr = r & 15, cc = c & 31, ob = rr * 64 + cc * 2; return st * 1024 + (ob ^ (((ob >> 9) & 1) << 5)); }
__host__ __device__ __forceinline__ void stage_rc(int b, int& R, int& C) { const int st = b / 1024, sb = b % 1024, swz = sb ^ (((sb >> 9) & 1) << 5); R = (st >> 1) * 16 + swz / 64; C = (st & 1) * 32 + (swz % 64) / 2; }
__host__ __device__ __forceinline__ int perm32(int rho) { const int n = rho >> 4, i = rho & 15; return 8 * (i >> 2) + 4 * n + (i & 3); }

struct Unit { int pm, pn; };
struct Gemm { const bf16_t* A; const bf16_t* Bt; int M, N, K; };

struct StaticOrder {
    int nM, nN, nwg, G, c;
    __host__ __device__ void init(int M, int N, int G_, int c_) { nM = M / BM; nN = N / BM; nwg = nM * nN; G = G_; c = c_; }
    __host__ __device__ bool next(int i, Unit& u) const {
        const long L = (long)i * G + c; if (L >= nwg) return false;
        int wgid = (int)L; { const int q = nwg / NXCD, r = nwg % NXCD, xcd = wgid % NXCD, off = wgid / NXCD; wgid = (xcd < r ? xcd * (q + 1) : r * (q + 1) + (xcd - r) * q) + off; }
        const int nig = WGM * nN, gid = wgid / nig, fm = gid * WGM, gsz = (nM - fm) < WGM ? (nM - fm) : WGM;
        u.pm = fm + ((wgid % nig) % gsz); u.pn = (wgid % nig) / gsz; return true;
    }
    __device__ __forceinline__ void a_ready(const Unit&) const {}
    __device__ __forceinline__ void done(const Unit&) const {}
};
typedef __bf16 bf16x2c_t __attribute__((ext_vector_type(2))); typedef float f32x2c_t __attribute__((ext_vector_type(2)));
__device__ __forceinline__ unsigned cvt_pk_bf16(float lo, float hi) { return __builtin_bit_cast(unsigned, __builtin_convertvector((f32x2c_t){lo, hi}, bf16x2c_t)); }
typedef float f32x2 __attribute__((ext_vector_type(2)));
template <class Epi, class Sched, bool STAMP = false>
__device__ __forceinline__ void gemm_phase(PG8_LAS unsigned char* lds, const Gemm g, const Sched& S, const Epi& E, unsigned long long* stamps) {
    int tid = threadIdx.x; asm volatile("" : "+v"(tid)); const int wid = __builtin_amdgcn_readfirstlane(tid >> 6), lane = tid & 63, wr = wid >> 2, wc = wid & 3, fr = lane & 15, fq = lane >> 4;
    const int K = g.K, nt = K / BK;
    int ts_lo = 0, ts_hi = 0, nts = 0; const unsigned long long rt_entry = STAMP ? (unsigned long long)wall_clock64() : 0ull;
#define PG8_STAMP() do { if (STAMP && wid == 0 && nts < 64) { const unsigned long long _c = (unsigned long long)clock64(); \
        ts_lo = (lane == nts) ? (int)(unsigned)_c : ts_lo; ts_hi = (lane == nts) ? (int)(unsigned)(_c >> 32) : ts_hi; ++nts; } } while (0)
    PG8_STAMP();
    unsigned voffA[2], voffB[2];
#pragma unroll
    for (int i = 0; i < 2; ++i) { int R, C; stage_rc(tid * 16 + i * 8192, R, C); const int Rb = Epi::PERM ? ((R & ~31) + perm32(R & 31)) : R;
        voffA[i] = (unsigned)(R * K + C) * 2u; voffB[i] = (unsigned)(Rb * K + C) * 2u; }
    const size_t kstep = (size_t)(BK * 2);
    const size_t hstep = (size_t)HALF * K * 2;
    const size_t tstep = 2 * hstep;
    const unsigned ldsw = (unsigned)wid * 1024u;
    const int aoff = lds_byte(wr * 64 + fr, fq * 8), boff = lds_byte(wc * 32 + fr, fq * 8);
#define PG8_SA(b, h) (((b) * 2 + (h)) * HTB)
#define PG8_SB(b, h) ((4 + (b) * 2 + (h)) * HTB)
#define PG8_STAGE(bufoff, gbase, voff) do { _Pragma("unroll") for (int _i = 0; _i < 2; ++_i) \
        __builtin_amdgcn_global_load_lds((const unsigned*)((const char*)(gbase) + (voff)[_i]), (PG8_LAS unsigned*)(lds + (bufoff) + ldsw + _i * 8192), 16, 0, 0); } while (0)
#define PG8_LDA(dst, b, h) do { _Pragma("unroll") for (int m = 0; m < 4; ++m) _Pragma("unroll") for (int k = 0; k < 2; ++k) dst[m][k] = *(const PG8_LAS bf16x8*)(lds + PG8_SA(b, h) + aoff + m * 2048 + k * 1024); } while (0)
#define PG8_LDB(dst, b, h) do { _Pragma("unroll") for (int n = 0; n < 2; ++n) _Pragma("unroll") for (int k = 0; k < 2; ++k) dst[n][k] = *(const PG8_LAS bf16x8*)(lds + PG8_SB(b, h) + boff + n * 2048 + k * 1024); } while (0)
#define PG8_MMA(ai, bj, At, Bt) do { __builtin_amdgcn_s_setprio(1); _Pragma("unroll") for (int m = 0; m < 4; ++m) _Pragma("unroll") for (int n = 0; n < 2; ++n) _Pragma("unroll") for (int k = 0; k < 2; ++k) \
        acc[ai][bj][m][n] = __builtin_amdgcn_mfma_f32_16x16x32_bf16(Bt[n][k], At[m][k], acc[ai][bj][m][n], 0, 0, 0); __builtin_amdgcn_s_setprio(0); } while (0)
#define PG8_WAIT_V(n) asm volatile("s_waitcnt vmcnt(" #n ")" ::: "memory")
#define PG8_WAIT_L(n) asm volatile("s_waitcnt lgkmcnt(" #n ")" ::: "memory")
#define PG8_BAR __builtin_amdgcn_s_barrier()
#define PG8_SCHED __builtin_amdgcn_sched_barrier(0)
    Unit cur, nxt; int ui = 0;
    if (!S.next(0, cur)) return;
    f32x4 acc[2][2][4][2];
#pragma unroll
    for (int a = 0; a < 2; ++a)
#pragma unroll
        for (int b = 0; b < 2; ++b)
#pragma unroll
            for (int m = 0; m < 4; ++m)
#pragma unroll
                for (int n = 0; n < 2; ++n) acc[a][b][m][n] = (f32x4){0.f, 0.f, 0.f, 0.f};
    bf16x8 At[4][2], B0[2][2], B1[2][2];
    const char* cA = (const char*)g.A + (size_t)cur.pm * tstep; const char* cB = (const char*)g.Bt + (size_t)cur.pn * tstep;
    S.a_ready(cur);
    PG8_STAGE(PG8_SB(0, 0), cB, voffB); PG8_STAGE(PG8_SA(0, 0), cA, voffA); PG8_STAGE(PG8_SB(0, 1), cB + hstep, voffB); PG8_STAGE(PG8_SA(0, 1), cA + hstep, voffA);
    if (wr == 1) PG8_BAR;
    PG8_WAIT_V(4); PG8_BAR;
    PG8_STAGE(PG8_SB(1, 0), cB + kstep, voffB); PG8_STAGE(PG8_SA(1, 0), cA + kstep, voffA); PG8_STAGE(PG8_SB(1, 1), cB + hstep + kstep, voffB);
    PG8_WAIT_V(6); PG8_BAR;
    PG8_STAMP();
    for (;;) {
        const bool has_next = S.next(ui + 1, nxt);
        const char* nA = has_next ? (const char*)g.A + (size_t)nxt.pm * tstep : cA; const char* nB = has_next ? (const char*)g.Bt + (size_t)nxt.pn * tstep : cB;
        for (int t = 0; t < nt; t += 2) {
            const bool last = (t == nt - 2);
            const char* a1 = cA + (size_t)(t + 1) * kstep;
            const char* a2 = last ? nA : cA + (size_t)(t + 2) * kstep; const char* b2 = last ? nB : cB + (size_t)(t + 2) * kstep;
            const char* a3 = a2 + kstep; const char* b3 = b2 + kstep;
            if (last && has_next) S.a_ready(nxt);
            PG8_LDB(B0, 0, 0); PG8_SCHED; PG8_LDA(At, 0, 0); PG8_STAGE(PG8_SA(1, 1), a1 + hstep, voffA);
            PG8_WAIT_L(8); PG8_BAR; PG8_WAIT_L(0); PG8_MMA(0, 0, At, B0); PG8_BAR; PG8_SCHED;
            PG8_LDB(B1, 0, 1); PG8_STAGE(PG8_SB(0, 0), b2, voffB);
            PG8_BAR; PG8_WAIT_L(0); PG8_MMA(0, 1, At, B1); PG8_BAR;
            PG8_LDA(At, 0, 1); PG8_STAGE(PG8_SA(0, 0), a2, voffA);
            PG8_BAR; PG8_WAIT_L(0); PG8_MMA(1, 0, At, B0); PG8_BAR; PG8_SCHED;
            PG8_STAGE(PG8_SB(0, 1), b2 + hstep, voffB);
            PG8_WAIT_V(6); PG8_BAR; PG8_MMA(1, 1, At, B1); PG8_BAR;
            PG8_LDB(B0, 1, 0); PG8_SCHED; PG8_LDA(At, 1, 0); PG8_STAGE(PG8_SA(0, 1), a2 + hstep, voffA);
            PG8_WAIT_L(8); PG8_BAR; PG8_WAIT_L(0); PG8_MMA(0, 0, At, B0); PG8_BAR; PG8_SCHED;
            PG8_LDB(B1, 1, 1); PG8_STAGE(PG8_SB(1, 0), b3, voffB);
            PG8_BAR; PG8_WAIT_L(0); PG8_MMA(0, 1, At, B1); PG8_BAR;
            PG8_LDA(At, 1, 1); PG8_STAGE(PG8_SA(1, 0), a3, voffA);
            PG8_BAR; PG8_WAIT_L(0); PG8_MMA(1, 0, At, B0); PG8_BAR; PG8_SCHED;
            PG8_STAGE(PG8_SB(1, 1), b3 + hstep, voffB);
            PG8_WAIT_V(6); PG8_BAR; PG8_MMA(1, 1, At, B1); PG8_BAR;
        }
        PG8_STAMP();
        if constexpr (!Epi::AFTER_DRAIN) { E(acc, cur, wr, wc, fr, fq); S.done(cur); }
        PG8_STAMP();
        if (!has_next) break;
#pragma unroll
        for (int a = 0; a < 2; ++a)
#pragma unroll
            for (int b = 0; b < 2; ++b)
#pragma unroll
                for (int m = 0; m < 4; ++m)
#pragma unroll
                    for (int n = 0; n < 2; ++n) acc[a][b][m][n] = (f32x4){0.f, 0.f, 0.f, 0.f};
        cur = nxt; cA = nA; cB = nB; ++ui;
    }
    PG8_WAIT_V(0);
    if (wr == 0) PG8_BAR;
    PG8_BAR;
    if constexpr (Epi::AFTER_DRAIN) { E.fused(acc, cur, wr, wc, fr, fq, lds, wid, lane); S.done(cur); }
    PG8_STAMP();
    if (STAMP && wid == 0) { stamps[lane] = lane < nts ? (((unsigned long long)(unsigned)ts_hi << 32) | (unsigned)ts_lo) : 0ull;
        if (lane == 62) stamps[62] = rt_entry; if (lane == 63) stamps[63] = (unsigned long long)wall_clock64(); }
#undef PG8_STAMP
#undef PG8_SA
#undef PG8_SB
#undef PG8_STAGE
#undef PG8_LDA
#undef PG8_LDB
#undef PG8_MMA
#undef PG8_WAIT_V
#undef PG8_WAIT_L
#undef PG8_BAR
#undef PG8_SCHED
}
}

typedef unsigned short bf16_t;
typedef float f32x4 __attribute__((ext_vector_type(4)));
__device__ __forceinline__ int opaque_tid() { int t = threadIdx.x; asm volatile("" : "+v"(t)); return t; }
typedef unsigned u32x4 __attribute__((ext_vector_type(4)));

__device__ __forceinline__ bf16_t f2bf(float f) { return __builtin_bit_cast(bf16_t, (__bf16)f); }
typedef __bf16 bf16x2n_t __attribute__((ext_vector_type(2)));
typedef float f32x2n_t __attribute__((ext_vector_type(2)));
__device__ __forceinline__ unsigned pack2bf(float lo, float hi) { return __builtin_bit_cast(unsigned, __builtin_convertvector((f32x2n_t){lo, hi}, bf16x2n_t)); }
__device__ __forceinline__ float bf2f(bf16_t b) { return __uint_as_float(((unsigned)b) << 16); }
__device__ __forceinline__ float sigmoidf_(float x) { return __builtin_amdgcn_rcpf(1.f + __expf(-x)); }
__device__ __forceinline__ float gelu_tanh(float x) {
    float u = 0.7978845608028654f * (x + 0.044715f * x * x * x);
    return 0.5f * x * (1.f + tanhf(u));
}
__device__ __forceinline__ float gelu_erf(float x) { return 0.5f * x * (1.f + erff(x * 0.70710678118654752f)); }
__device__ __forceinline__ float gelu_as(float v) {
    const float av = fabsf(v), d = av * 0.2316418882f + 1.0f;
    const float t = __builtin_amdgcn_rcpf(d);
    float q = t * 0.5307027145f + (-0.7265760135f); q = q * t + 0.7107068705f; q = q * t + (-0.142248368f); q = q * t + 0.127414796f; q = q * t;
    const float e = __builtin_amdgcn_exp2f((v * v) * (-0.72134752044f));
    const float m = v * (q * e), r = v - m;
    return v < 0.f ? m : r;
}

struct EpiResF32 {
    static constexpr bool PERM = false, AFTER_DRAIN = false;
    float* C; int ldc; const float* X; float alpha;
    __device__ __forceinline__ void operator()(const pg8::f32x4 (&acc)[2][2][4][2], const pg8::Unit& u, int wr, int wc, int fr, int fq) const {
        const int row0 = u.pm * pg8::BM + wr * 64 + fr, col0 = u.pn * pg8::BM + wc * 32 + 4 * fq;
#pragma unroll
        for (int ai = 0; ai < 2; ++ai)
#pragma unroll
            for (int m = 0; m < 4; ++m) {
                const size_t ro = (size_t)(row0 + ai * pg8::HALF + m * 16) * ldc + col0;
#pragma unroll
                for (int bj = 0; bj < 2; ++bj)
#pragma unroll
                    for (int n = 0; n < 2; ++n) {
                        const pg8::f32x4 xv = *(const pg8::f32x4*)(X + ro + bj * pg8::HALF + n * 16);
                        *(pg8::f32x4*)(C + ro + bj * pg8::HALF + n * 16) = acc[ai][bj][m][n] + xv * alpha;
                    }
            }
    }
};
struct EpiBf16 {
    static constexpr bool PERM = true, AFTER_DRAIN = false;
    bf16_t* O; int ldc;
    __device__ __forceinline__ void operator()(const pg8::f32x4 (&acc)[2][2][4][2], const pg8::Unit& u, int wr, int wc, int fr, int fq) const {
        const int row0 = u.pm * pg8::BM + wr * 64 + fr;
        const int col0 = u.pn * pg8::BM + wc * 32 + 8 * fq;
#pragma unroll
        for (int ai = 0; ai < 2; ++ai)
#pragma unroll
            for (int m = 0; m < 4; ++m) {
                bf16_t* rowp = O + (size_t)(row0 + ai * pg8::HALF + m * 16) * ldc + col0;
#pragma unroll
                for (int bj = 0; bj < 2; ++bj) {
                    const pg8::f32x4 v0 = acc[ai][bj][m][0], v1 = acc[ai][bj][m][1];
                    pg8::u32x4 w; w.x = pg8::cvt_pk_bf16(v0[0], v0[1]); w.y = pg8::cvt_pk_bf16(v0[2], v0[3]); w.z = pg8::cvt_pk_bf16(v1[0], v1[1]); w.w = pg8::cvt_pk_bf16(v1[2], v1[3]);
                    *(pg8::u32x4*)(rowp + bj * pg8::HALF) = w;
                }
            }
    }
};

__device__ __forceinline__ void cvt_unit(size_t unit, const float* __restrict__ src, bf16_t* __restrict__ dst) {
    const size_t o = unit * 4096 + (size_t)threadIdx.x * 8;
    const f32x4 a = *(const f32x4*)(src + o), b = *(const f32x4*)(src + o + 4);
    u32x4 w; w.x = pack2bf(a[0], a[1]); w.y = pack2bf(a[2], a[3]); w.z = pack2bf(b[0], b[1]); w.w = pack2bf(b[2], b[3]);
    *(u32x4*)(dst + o) = w;
}
__device__ __forceinline__ void transpose_unit(int unit, const float* __restrict__ in, bf16_t* __restrict__ out, int R, int C, float* tile  ,
                                               const float* __restrict__ rowscale = nullptr, const float* __restrict__ rowbias = nullptr, float* __restrict__ p1 = nullptr, float* __restrict__ p2 = nullptr) {
    const int ntc = C / 64;
    const int r0 = (unit / ntc) * 64, c0 = (unit % ntc) * 64;
    float* tile2 = tile + 64 * 65;
    __syncthreads();
#pragma unroll
    for (int i = 0; i < 8; i++) {
        int e = threadIdx.x + i * NTHR;
        int r = e >> 6, c = e & 63;
        const float v = in[(size_t)(r0 + r) * C + c0 + c];
        tile[r * 65 + c] = rowscale ? v * rowscale[r0 + r] : v;
        if (rowscale) tile2[r * 65 + c] = v * rowbias[r0 + r];
    }
    __syncthreads();
#pragma unroll
    for (int i = 0; i < 8; i++) {
        int e = threadIdx.x + i * NTHR;
        int c = e >> 6, r = e & 63;
        out[(size_t)(c0 + c) * R + r0 + r] = f2bf(tile[r * 65 + c]);
    }
    if (rowscale && threadIdx.x < 64) {
        float s1 = 0.f, s2 = 0.f;
        for (int r = 0; r < 64; ++r) { s1 += tile[r * 65 + threadIdx.x]; s2 += tile2[r * 65 + threadIdx.x]; }
        p1[(size_t)(r0 / 64) * C + c0 + threadIdx.x] = s1;
        p2[(size_t)(r0 / 64) * C + c0 + threadIdx.x] = s2;
    }
}

typedef __bf16 bf16x2_t __attribute__((ext_vector_type(2)));
__device__ __forceinline__ float dot2bf(unsigned a, unsigned b, float c) { return __builtin_amdgcn_fdot2_f32_bf16(__builtin_bit_cast(bf16x2_t, a), __builtin_bit_cast(bf16x2_t, b), c, false); }
template <int CTRL> __device__ __forceinline__ float dppf(float x) { return __builtin_bit_cast(float, __builtin_amdgcn_mov_dpp(__builtin_bit_cast(int, x), CTRL, 0xf, 0xf, true)); }
#define DPP_XOR1 0xB1
#define DPP_XOR2 0x4E
#define DPP_XOR7 0x141
#define DPP_XOR8 0x128
__device__ __forceinline__ float xrow16_sum(float x) {
    auto s = __builtin_amdgcn_permlane16_swap(__float_as_uint(x), __float_as_uint(x), false, false);
    x = __uint_as_float(s[0]) + __uint_as_float(s[1]);
    auto t = __builtin_amdgcn_permlane32_swap(__float_as_uint(x), __float_as_uint(x), false, false);
    return __uint_as_float(t[0]) + __uint_as_float(t[1]);
}
__device__ __forceinline__ float wave_sum(float x) {
    x += dppf<DPP_XOR1>(x); x += dppf<DPP_XOR2>(x); x += dppf<DPP_XOR7>(x); x += dppf<DPP_XOR8>(x);
    return xrow16_sum(x);
}
__device__ __forceinline__ float tr_reduce16(float (&p)[16], int c) {
#define TR_STEP(HALF, CTRL, BIT) _Pragma("unroll") for (int h = 0; h < (HALF); ++h) { \
        const float lo_ = p[h], hi_ = p[h + (HALF)]; const float t1_ = lo_ + dppf<CTRL>(lo_), t2_ = hi_ + dppf<CTRL>(hi_); \
        p[h] = (c & (BIT)) ? t2_ : t1_; }
    TR_STEP(8, DPP_XOR8, 8) TR_STEP(4, DPP_XOR7, 4) TR_STEP(2, DPP_XOR2, 2) TR_STEP(1, DPP_XOR1, 1)
#undef TR_STEP
    return xrow16_sum(p[0]);
}
#define G_LOAD(R, tab, idreg, k0) do { _Pragma("unroll") for (int j_ = 0; j_ < 8; ++j_) { \
        const int id_ = __builtin_amdgcn_readlane((idreg), (k0) + j_); \
        const u32x4* rp_ = (const u32x4*)((tab) + (size_t)id_ * 1024); \
        R[j_][0] = rp_[lane]; R[j_][1] = rp_[64 + lane]; } } while (0)
#define G_DOT(R, p, o) do { _Pragma("unroll") for (int j_ = 0; j_ < 8; ++j_) { \
        float d0_ = dot2bf(R[j_][0].x, xp[0], 0.f), d1_ = dot2bf(R[j_][0].y, xp[1], 0.f); \
        d0_ = dot2bf(R[j_][0].z, xp[2], d0_); d1_ = dot2bf(R[j_][0].w, xp[3], d1_); \
        d0_ = dot2bf(R[j_][1].x, xp[4], d0_); d1_ = dot2bf(R[j_][1].y, xp[5], d1_); \
        d0_ = dot2bf(R[j_][1].z, xp[6], d0_); d1_ = dot2bf(R[j_][1].w, xp[7], d1_); \
        p[(o) + j_] = d0_ + d1_; } } while (0)
#define G_ACC1(u_, i_, w_) do { y[(i_)] = fmaf((w_), __uint_as_float((u_) << 16), y[(i_)]); y[(i_) + 1] = fmaf((w_), __uint_as_float((u_) & 0xffff0000u), y[(i_) + 1]); } while (0)
#define G_ACC(R, wreg, k0) do { _Pragma("unroll") for (int j_ = 0; j_ < 8; ++j_) { \
        const float w_ = __uint_as_float((unsigned)__builtin_amdgcn_readlane((int)__float_as_uint(wreg), (k0) + j_)); \
        G_ACC1(R[j_][0].x, 0, w_); G_ACC1(R[j_][0].y, 2, w_); G_ACC1(R[j_][0].z, 4, w_); G_ACC1(R[j_][0].w, 6, w_); \
        G_ACC1(R[j_][1].x, 8, w_); G_ACC1(R[j_][1].y, 10, w_); G_ACC1(R[j_][1].z, 12, w_); G_ACC1(R[j_][1].w, 14, w_); } } while (0)

typedef short bf16x8_t __attribute__((ext_vector_type(8)));
typedef float f32x16 __attribute__((ext_vector_type(16)));
#define HG_P272 272
#define HG_P144 144
#define HG_QH   0
#define HG_KH   (HG_QH + 64 * 272)
#define HG_QT   (HG_KH + 64 * 272)
#define HG_VT   (HG_QT + 64 * 272)
#define HG_ST   (HG_VT + 128 * 144)
#define HG_PM   (HG_ST + 128 * 272)
#define HG_SEG  (HG_PM + 64 * 144)
#define HG_RSQ  (HG_SEG + 4096)
#define HG_END  (HG_RSQ + 1024)

__device__ __forceinline__ float hg_lb(const float* __restrict__ lbl, int c) { return 1.f / (1.f + __expf(lbl[512 + c] - lbl[c])); }
__device__ __forceinline__ float sel4(const float (&v)[4], int k) { return k == 0 ? v[0] : k == 1 ? v[1] : k == 2 ? v[2] : v[3]; }
__device__ __forceinline__ float pklo(unsigned w) { return __uint_as_float(w << 16); }
__device__ __forceinline__ float pkhi(unsigned w) { return __uint_as_float(w & 0xffff0000u); }
__device__ __forceinline__ void hg_prep(const unsigned (&fw)[8], float lb0, float lb1, int dp, int ts, float* seg  ,
                                        float (&kk)[16], float (&bb)[16], float (&tot)[2], float (&bref)[2]) {
    float run0 = 0.f, run1 = 0.f;
#pragma unroll
    for (int i = 0; i < 8; ++i) {
        const float s0 = sigmoidf_(pklo(fw[i])), s1 = sigmoidf_(pkhi(fw[i]));
        kk[2 * i] = (1.f - lb0) * (1.f - s0); kk[2 * i + 1] = (1.f - lb1) * (1.f - s1);
        run0 += __logf(lb0 + (1.f - lb0) * s0); run1 += __logf(lb1 + (1.f - lb1) * s1);
        bb[2 * i] = run0; bb[2 * i + 1] = run1;
    }
    *(float2*)(seg + ts * 128 + 2 * dp) = make_float2(run0, run1);
    __syncthreads();
    float pre0 = 0.f, pre1 = 0.f, t0 = 0.f, t1 = 0.f, r0 = 0.f, r1 = 0.f;
#pragma unroll
    for (int s = 0; s < 8; ++s) {
        const float2 v = *(const float2*)(seg + s * 128 + 2 * dp);
        if (s < ts) { pre0 += v.x; pre1 += v.y; }
        if (s < 4) { r0 += v.x; r1 += v.y; }
        t0 += v.x; t1 += v.y;
    }
    tot[0] = t0; tot[1] = t1; bref[0] = r0; bref[1] = r1;
#pragma unroll
    for (int i = 0; i < 8; ++i) { bb[2 * i] += pre0; bb[2 * i + 1] += pre1; }
}
__device__ __forceinline__ void hg_store8x2(unsigned char* base, int dp, int ts, const float (&v)[16]) {
    u32x4 w0, w1;
    w0.x = pack2bf(v[0], v[2]); w0.y = pack2bf(v[4], v[6]); w0.z = pack2bf(v[8], v[10]); w0.w = pack2bf(v[12], v[14]);
    w1.x = pack2bf(v[1], v[3]); w1.y = pack2bf(v[5], v[7]); w1.z = pack2bf(v[9], v[11]); w1.w = pack2bf(v[13], v[15]);
    *(u32x4*)(base + (2 * dp) * HG_P144 + ts * 16) = w0;
    *(u32x4*)(base + (2 * dp + 1) * HG_P144 + ts * 16) = w1;
}
__device__ __forceinline__ void hg_store8x2_raw(unsigned char* base, int dp, int ts, const unsigned (&p)[8]) {
    u32x4 w0, w1;
    w0.x = __builtin_amdgcn_perm(p[1], p[0], 0x05040100u); w0.y = __builtin_amdgcn_perm(p[3], p[2], 0x05040100u);
    w0.z = __builtin_amdgcn_perm(p[5], p[4], 0x05040100u); w0.w = __builtin_amdgcn_perm(p[7], p[6], 0x05040100u);
    w1.x = __builtin_amdgcn_perm(p[1], p[0], 0x07060302u); w1.y = __builtin_amdgcn_perm(p[3], p[2], 0x07060302u);
    w1.z = __builtin_amdgcn_perm(p[5], p[4], 0x07060302u); w1.w = __builtin_amdgcn_perm(p[7], p[6], 0x07060302u);
    *(u32x4*)(base + (2 * dp) * HG_P144 + ts * 16) = w0;
    *(u32x4*)(base + (2 * dp + 1) * HG_P144 + ts * 16) = w1;
}
__device__ __forceinline__ void hg_store16(unsigned char* base, int col, int tq, const float (&v)[16]) {
    u32x4 w0, w1;
    w0.x = pack2bf(v[0], v[1]); w0.y = pack2bf(v[2], v[3]); w0.z = pack2bf(v[4], v[5]); w0.w = pack2bf(v[6], v[7]);
    w1.x = pack2bf(v[8], v[9]); w1.y = pack2bf(v[10], v[11]); w1.z = pack2bf(v[12], v[13]); w1.w = pack2bf(v[14], v[15]);
    *(u32x4*)(base + col * HG_P144 + tq * 32) = w0;
    *(u32x4*)(base + col * HG_P144 + tq * 32 + 16) = w1;
}
__device__ __forceinline__ bf16x8_t hg_frag(const unsigned char* base, int pitch, int row, int kelem) {
    return *(const bf16x8_t*)(base + row * pitch + kelem * 2);
}

struct HgP2Regs { unsigned f[8], v[8]; };
__device__ __forceinline__ void hgrn_p2_load(int unit, const bf16_t* __restrict__ h, HgP2Regs& R) {
    const int b = unit >> 9, hh = (unit >> 7) & 3, ch = unit & 127;
    const int tx = opaque_tid();
    const int dp = tx & 63, ts = tx >> 6;
    const size_t t0 = (size_t)b * SEQ + ch * 64 + ts * 8;
#pragma unroll
    for (int i = 0; i < 8; ++i) {
        const unsigned* hr = (const unsigned*)(h + (t0 + i) * INW + hh * 128) + dp;
        R.f[i] = hr[1536 / 2]; R.v[i] = hr[2048 / 2];
    }
}
__device__ __forceinline__ void hgrn_p2_body(int unit, const HgP2Regs& R, const float (&lb4)[2][4], bf16_t* __restrict__ kv, float* __restrict__ gam, unsigned char* lds) {
    const int hh = (unit >> 7) & 3;
    const int tx = opaque_tid();
    const int dp = tx & 63, ts = tx >> 6;
    const int lane = tx & 63, w = tx >> 6;
    __syncthreads();
    float kk[16], bb[16], tot[2], bref[2];
    hg_prep(R.f, sel4(lb4[0], hh), sel4(lb4[1], hh), dp, ts, (float*)(lds + HG_SEG), kk, bb, tot, bref);
    float tmp[16];
#pragma unroll
    for (int i = 0; i < 16; ++i) tmp[i] = kk[i] * __expf(tot[i & 1] - bb[i]);
    hg_store8x2(lds + HG_ST, dp, ts, tmp);
    hg_store8x2_raw(lds + HG_VT, dp, ts, R.v);
    if (ts == 0) *(float2*)(gam + (size_t)unit * 128 + 2 * dp) = make_float2(__expf(tot[0]), __expf(tot[1]));
    __syncthreads();
    const int mt = w >> 1;
    f32x16 acc[2];
#pragma unroll
    for (int n = 0; n < 2; ++n)
#pragma unroll
        for (int r = 0; r < 16; ++r) acc[n][r] = 0.f;
#pragma unroll
    for (int ks = 0; ks < 4; ++ks) {
        const int kel = ks * 16 + 8 * (lane >> 5);
        const bf16x8_t a = hg_frag(lds + HG_VT, HG_P144, mt * 32 + (lane & 31), kel);
#pragma unroll
        for (int n = 0; n < 2; ++n) {
            const int nt = 2 * (w & 1) + n;
            const bf16x8_t bf = hg_frag(lds + HG_ST, HG_P144, nt * 32 + (lane & 31), kel);
            acc[n] = __builtin_amdgcn_mfma_f32_32x32x16_bf16(a, bf, acc[n], 0, 0, 0);
        }
    }
    bf16_t* o = kv + (size_t)unit * 16384;
#pragma unroll
    for (int n = 0; n < 2; ++n) {
        const int nt = 2 * (w & 1) + n;
#pragma unroll
        for (int r = 0; r < 16; ++r) {
            const int e = mt * 32 + (r & 3) + 8 * (r >> 2) + 4 * (lane >> 5);
            o[e * 128 + nt * 32 + (lane & 31)] = f2bf(acc[n][r]);
        }
    }
}

__device__ void hgrn_scan4(int tid256, bf16_t* __restrict__ kv, const float* __restrict__ gam) {
    const int gid = blockIdx.x * 256 + tid256;
    const int bh = gid >> 12, rem = gid & 4095;
    const int d = (rem & 31) * 4;
    uint2* p = (uint2*)(kv + (size_t)bh * 128 * 16384) + rem;
    const float* gp = gam + (size_t)bh * 128 * 128 + d;
    float s0 = 0.f, s1 = 0.f, s2 = 0.f, s3 = 0.f;
    for (int c0 = 0; c0 < 128; c0 += 8) {
        uint2 kvv[8]; f32x4 g[8];
#pragma unroll
        for (int j = 0; j < 8; ++j) { kvv[j] = p[(size_t)(c0 + j) * 4096]; g[j] = *(const f32x4*)(gp + (c0 + j) * 128); }
#pragma unroll
        for (int j = 0; j < 8; ++j) {
            uint2 o; o.x = pack2bf(s0, s1); o.y = pack2bf(s2, s3);
            p[(size_t)(c0 + j) * 4096] = o;
            s0 = fmaf(g[j][0], s0, __uint_as_float(kvv[j].x << 16));
            s1 = fmaf(g[j][1], s1, __uint_as_float(kvv[j].x & 0xffff0000u));
            s2 = fmaf(g[j][2], s2, __uint_as_float(kvv[j].y << 16));
            s3 = fmaf(g[j][3], s3, __uint_as_float(kvv[j].y & 0xffff0000u));
        }
    }
}

struct HgP4Regs { u32x4 stv[4]; unsigned f[8], q[8], v[8]; bf16_t gvr[16]; };
__device__ __forceinline__ void hgrn_p4_load(int unit, const bf16_t* __restrict__ h, const bf16_t* __restrict__ st, HgP4Regs& R) {
    const int b = unit >> 9, hh = (unit >> 7) & 3, ch = unit & 127;
    const int tx = opaque_tid();
    const int dp = tx & 63, ts = tx >> 6;
    const int lane = tx & 63, w = tx >> 6;
    const size_t tb = (size_t)b * SEQ + ch * 64;
    const size_t t0 = tb + ts * 8;
    const int mt = w >> 2, nt = w & 3;
    const u32x4* sp = (const u32x4*)(st + (size_t)unit * 16384);
#pragma unroll
    for (int i = 0; i < 4; ++i) R.stv[i] = sp[tx + i * NTHR];
#pragma unroll
    for (int i = 0; i < 8; ++i) {
        const unsigned* hr = (const unsigned*)(h + (t0 + i) * INW + hh * 128) + dp;
        R.f[i] = hr[1536 / 2]; R.q[i] = hr[1024 / 2]; R.v[i] = hr[2048 / 2];
    }
#pragma unroll
    for (int r = 0; r < 16; ++r) R.gvr[r] = h[(tb + mt * 32 + (r & 3) + 8 * (r >> 2) + 4 * (lane >> 5)) * INW + 2560 + hh * 128 + nt * 32 + (lane & 31)];
}
__device__ __forceinline__ void hgrn_p4_body(int unit, const HgP4Regs& R, const float (&lb4)[2][4], const float (&gn4)[4], bf16_t* __restrict__ mixin, unsigned char* lds) {
    const int b = unit >> 9, hh = (unit >> 7) & 3, ch = unit & 127;
    const int tx = opaque_tid();
    const int dp = tx & 63, ts = tx >> 6;
    const int lane = tx & 63, w = tx >> 6;
    const size_t tb = (size_t)b * SEQ + ch * 64;
    const int mt = w >> 2, nt = w & 3;
    __syncthreads();
    float kk[16], bb[16], tot[2], bref[2];
    hg_prep(R.f, sel4(lb4[0], hh), sel4(lb4[1], hh), dp, ts, (float*)(lds + HG_SEG), kk, bb, tot, bref);
#pragma unroll
    for (int i = 0; i < 8; ++i) {
        const float q0 = pklo(R.q[i]), q1 = pkhi(R.q[i]);
        const int t = ts * 8 + i;
        *(unsigned*)(lds + HG_QH + t * HG_P272 + dp * 4) = pack2bf(q0 * __expf(bb[2 * i] - bref[0]), q1 * __expf(bb[2 * i + 1] - bref[1]));
        *(unsigned*)(lds + HG_KH + t * HG_P272 + dp * 4) = pack2bf(kk[2 * i] * __expf(bref[0] - bb[2 * i]), kk[2 * i + 1] * __expf(bref[1] - bb[2 * i + 1]));
        *(unsigned*)(lds + HG_QT + t * HG_P272 + dp * 4) = pack2bf(q0 * __expf(bb[2 * i]), q1 * __expf(bb[2 * i + 1]));
    }
    hg_store8x2_raw(lds + HG_VT, dp, ts, R.v);
    {
#pragma unroll
        for (int i = 0; i < 4; ++i) {
            const int pc = tx + i * NTHR;
            *(u32x4*)(lds + HG_ST + (pc >> 4) * HG_P272 + (pc & 15) * 16) = R.stv[i];
        }
    }
    __syncthreads();
    f32x16 acc;
#pragma unroll
    for (int r = 0; r < 16; ++r) acc[r] = 0.f;
#pragma unroll
    for (int ks = 0; ks < 8; ++ks) {
        const int kel = ks * 16 + 8 * (lane >> 5);
        const bf16x8_t a = hg_frag(lds + HG_QT, HG_P272, mt * 32 + (lane & 31), kel);
        const bf16x8_t bf = hg_frag(lds + HG_ST, HG_P272, nt * 32 + (lane & 31), kel);
        acc = __builtin_amdgcn_mfma_f32_32x32x16_bf16(a, bf, acc, 0, 0, 0);
    }
    if (w < 4) {
        const int pm = w >> 1, pn = w & 1;
        f32x16 pa;
#pragma unroll
        for (int r = 0; r < 16; ++r) pa[r] = 0.f;
#pragma unroll
        for (int ks = 0; ks < 8; ++ks) {
            const int kel = ks * 16 + 8 * (lane >> 5);
            const bf16x8_t a = hg_frag(lds + HG_QH, HG_P272, pm * 32 + (lane & 31), kel);
            const bf16x8_t bf = hg_frag(lds + HG_KH, HG_P272, pn * 32 + (lane & 31), kel);
            pa = __builtin_amdgcn_mfma_f32_32x32x16_bf16(a, bf, pa, 0, 0, 0);
        }
        const int s = pn * 32 + (lane & 31);
#pragma unroll
        for (int r = 0; r < 16; ++r) {
            const int t = pm * 32 + (r & 3) + 8 * (r >> 2) + 4 * (lane >> 5);
            const float pv = (s <= t) ? pa[r] : 0.f;
            *(bf16_t*)(lds + HG_PM + t * HG_P144 + s * 2) = f2bf(pv);
        }
    }
    __syncthreads();
#pragma unroll
    for (int ks = 0; ks < 4; ++ks) {
        const int kel = ks * 16 + 8 * (lane >> 5);
        const bf16x8_t a = hg_frag(lds + HG_PM, HG_P144, mt * 32 + (lane & 31), kel);
        const bf16x8_t bf = hg_frag(lds + HG_VT, HG_P144, nt * 32 + (lane & 31), kel);
        acc = __builtin_amdgcn_mfma_f32_32x32x16_bf16(a, bf, acc, 0, 0, 0);
    }
    float* rsq = (float*)(lds + HG_RSQ);
#pragma unroll
    for (int r = 0; r < 16; ++r) {
        float v = acc[r] * acc[r];
        v += dppf<DPP_XOR1>(v); v += dppf<DPP_XOR2>(v); v += dppf<DPP_XOR7>(v); v += dppf<DPP_XOR8>(v);
        auto sw = __builtin_amdgcn_permlane16_swap(__float_as_uint(v), __float_as_uint(v), false, false);
        v = __uint_as_float(sw[0]) + __uint_as_float(sw[1]);
        if ((lane & 31) == 0) rsq[(mt * 32 + (r & 3) + 8 * (r >> 2) + 4 * (lane >> 5)) * 4 + nt] = v;
    }
    __syncthreads();
    const int e = nt * 32 + (lane & 31);
    const float gn = sel4(gn4, hh);
#pragma unroll
    for (int r = 0; r < 16; ++r) {
        const int t = mt * 32 + (r & 3) + 8 * (r >> 2) + 4 * (lane >> 5);
        const f32x4 q4 = *(const f32x4*)(rsq + t * 4);
        const float rs = rsqrtf((q4[0] + q4[1] + q4[2] + q4[3]) * (1.f / 128.f) + 1e-5f);
        const float gv = bf2f(R.gvr[r]);
        const float y = acc[r] * rs * gn * (gv * sigmoidf_(gv));
        mixin[(tb + t) * DM + 512 + hh * 128 + e] = f2bf(y);
    }
}


#define HD __device__ __forceinline__
#ifndef HD
#define HD __host__ __device__ __forceinline__
#endif
HD void sort16_desc(float (&v)[16]) {
#pragma unroll
    for (int k = 2; k <= 16; k <<= 1) {
#pragma unroll
        for (int j = k >> 1; j > 0; j >>= 1) {
#pragma unroll
            for (int i = 0; i < 16; ++i) {
                const int l = i ^ j;
                if (l > i) {
                    const bool desc = ((i & k) == 0);
                    const float a = v[i], b = v[l];
                    const float hi = fmaxf(a, b), lo = fminf(a, b);
                    v[i] = desc ? hi : lo; v[l] = desc ? lo : hi;
                }
            }
        }
    }
}
HD void merge_top16(float (&L)[16], const float (&B)[16]) {
#pragma unroll
    for (int i = 0; i < 16; ++i) L[i] = fmaxf(L[i], B[15 - i]);
#pragma unroll
    for (int j = 8; j > 0; j >>= 1) {
#pragma unroll
        for (int i = 0; i < 16; ++i) {
            const int l = i ^ j;
            if (l > i) { const float a = L[i], b = L[l]; L[i] = fmaxf(a, b); L[l] = fminf(a, b); }
        }
    }
}
HD void insert16(float (&L)[16], float x) {
#pragma unroll
    for (int i = 0; i < 16; ++i) { const float hi = fmaxf(L[i], x); x = fminf(L[i], x); L[i] = hi; }
}

#define TK_SK    0
#define TK_LIST  (2 * 128 * 272)
#define TK_END   (TK_LIST + 2 * 128 * 64)
__device__ void topk_phase(const bf16_t* __restrict__ q, const bf16_t* __restrict__ skb, int* __restrict__ idx, float* __restrict__ gate, unsigned char* lds) {
    const int tx = opaque_tid();
    const int lane = tx & 63, w = tx >> 6;
    const int h = blockIdx.x & 7;
    __syncthreads();
    {
        const u32x4* sp = (const u32x4*)(skb + (size_t)h * 2 * 16384);
#pragma unroll
        for (int i = 0; i < 8; ++i) {
            const int pc = tx + i * NTHR;
            *(u32x4*)(lds + TK_SK + (pc >> 11) * (128 * 272) + ((pc >> 4) & 127) * 272 + (pc & 15) * 16) = sp[pc];
        }
    }
    __syncthreads();
    const int p = w & 1, tile = w >> 1;
    for (int tb = blockIdx.x >> 3; tb < T_TOK / 128; tb += (gridDim.x >> 3)) {
        {
            const int t = tb * 128 + tile * 32 + (lane & 31);
            bf16x8_t bq[8];
            const bf16_t* qp = q + (size_t)t * 2048 + h * 256 + p * 128 + 8 * (lane >> 5);
#pragma unroll
            for (int ks = 0; ks < 8; ++ks) bq[ks] = *(const bf16x8_t*)(qp + ks * 16);
            float L[16];
            const unsigned char* skp = lds + TK_SK + p * (128 * 272);
#pragma unroll
            for (int mt = 0; mt < 4; ++mt) {
                f32x16 acc;
#pragma unroll
                for (int r = 0; r < 16; ++r) acc[r] = 0.f;
#pragma unroll
                for (int ks = 0; ks < 8; ++ks) {
                    const bf16x8_t a = hg_frag(skp, 272, mt * 32 + (lane & 31), ks * 16 + 8 * (lane >> 5));
                    acc = __builtin_amdgcn_mfma_f32_32x32x16_bf16(a, bq[ks], acc, 0, 0, 0);
                }
                float v[16];
#pragma unroll
                for (int r = 0; r < 16; ++r) {
                    const unsigned n = (unsigned)(mt * 32 + (r & 3) + 8 * (r >> 2)) + 4u * (unsigned)(lane >> 5);
                    v[r] = __uint_as_float((__float_as_uint(acc[r]) & ~127u) | n);
                }
                sort16_desc(v);
                if (mt == 0) {
#pragma unroll
                    for (int r = 0; r < 16; ++r) L[r] = v[r];
                } else merge_top16(L, v);
            }
            float Bx[16];
#pragma unroll
            for (int k = 0; k < 16; ++k) Bx[k] = __shfl_xor(L[k], 32);
            merge_top16(L, Bx);
            if (lane < 32) {
                f32x4* lp = (f32x4*)(lds + TK_LIST + (p * 128 + tile * 32 + lane) * 64);
                lp[0] = (f32x4){L[0], L[1], L[2], L[3]}; lp[1] = (f32x4){L[4], L[5], L[6], L[7]};
                lp[2] = (f32x4){L[8], L[9], L[10], L[11]}; lp[3] = (f32x4){L[12], L[13], L[14], L[15]};
            }
        }
        __syncthreads();
        if (tx < 128) {
            const float* l0 = (const float*)(lds + TK_LIST) + tx * 16;
            const float* l1 = (const float*)(lds + TK_LIST) + (128 + tx) * 16;
            float s0[16], s1[16];
#pragma unroll
            for (int k = 0; k < 4; ++k) {
                const f32x4 a = *(const f32x4*)(l0 + 4 * k), b2 = *(const f32x4*)(l1 + 4 * k);
                s0[4 * k] = a[0]; s0[4 * k + 1] = a[1]; s0[4 * k + 2] = a[2]; s0[4 * k + 3] = a[3];
                s1[4 * k] = b2[0]; s1[4 * k + 1] = b2[1]; s1[4 * k + 2] = b2[2]; s1[4 * k + 3] = b2[3];
            }
            float C0[16], C1[16], C2[16], c48 = 0.f, c49 = 0.f;
            int cnt = 0;
#pragma unroll
            for (int i = 0; i < 16; ++i) {
#pragma unroll
                for (int j = 0; j < 16; ++j) {
                    if ((i + 1) * (j + 1) <= 16) {
                        const float cv = __uint_as_float((__float_as_uint(s0[i] + s1[j]) & ~255u) | (unsigned)(i * 16 + j));
                        if (cnt < 16) C0[cnt & 15] = cv; else if (cnt < 32) C1[cnt & 15] = cv; else if (cnt < 48) C2[cnt & 15] = cv; else if (cnt == 48) c48 = cv; else c49 = cv;
                        ++cnt;
                    }
                }
            }
            sort16_desc(C0); sort16_desc(C1); sort16_desc(C2);
            merge_top16(C0, C1); merge_top16(C0, C2);
            insert16(C0, c48); insert16(C0, c49);
            const float mx = __uint_as_float(__float_as_uint(C0[0]) & ~255u);
            float e[16]; float sum = 0.f;
#pragma unroll
            for (int k = 0; k < 16; ++k) { e[k] = __expf(__uint_as_float(__float_as_uint(C0[k]) & ~255u) - mx); sum += e[k]; }
            const float inv = 1.f / sum;
            int id[16];
#pragma unroll
            for (int k = 0; k < 16; ++k) {
                const unsigned pos = __float_as_uint(C0[k]) & 255u;
                const unsigned k0 = __float_as_uint(l0[pos >> 4]) & 127u, k1 = __float_as_uint(l1[pos & 15]) & 127u;
                id[k] = (int)(k0 * 128u + k1);
                e[k] *= inv;
            }
            const size_t o = ((size_t)(tb * 128 + tx) * 8 + h) * 16;
#pragma unroll
            for (int k = 0; k < 4; ++k) {
                *(u32x4*)(idx + o + 4 * k) = (u32x4){(unsigned)id[4 * k], (unsigned)id[4 * k + 1], (unsigned)id[4 * k + 2], (unsigned)id[4 * k + 3]};
                *(f32x4*)(gate + o + 4 * k) = (f32x4){e[4 * k], e[4 * k + 1], e[4 * k + 2], e[4 * k + 3]};
            }
        }
        __syncthreads();
    }
}


typedef float f32x2_t __attribute__((ext_vector_type(2)));
__device__ __forceinline__ unsigned pack_i8x4(float a, float b, float c, float d) {
    const int ia = (int)__builtin_rintf(a), ib = (int)__builtin_rintf(b), ic = (int)__builtin_rintf(c), id = (int)__builtin_rintf(d);
    return ((unsigned)ia & 0xffu) | (((unsigned)ib & 0xffu) << 8) | (((unsigned)ic & 0xffu) << 16) | ((unsigned)id << 24);
}

__device__ __forceinline__ void quant_row(const float* __restrict__ src, unsigned char* __restrict__ dst, float* __restrict__ inv, int row, int lane,
                                          const float* __restrict__ gcol = nullptr, const float* __restrict__ bcol = nullptr, float* __restrict__ cu1 = nullptr, float* __restrict__ cu2 = nullptr, bool as_int8 = false) {
    const float* rp = src + (size_t)row * 1024 + 16 * lane;
    f32x4 a[4];
#pragma unroll
    for (int i = 0; i < 4; ++i) a[i] = *(const f32x4*)(rp + 4 * i);
    if (gcol) {
        float t1 = 0.f, t2 = 0.f;
#pragma unroll
        for (int i = 0; i < 4; ++i) {
            const f32x4 gv = *(const f32x4*)(gcol + 16 * lane + 4 * i), bv = *(const f32x4*)(bcol + 16 * lane + 4 * i);
#pragma unroll
            for (int k = 0; k < 4; ++k) { t2 += a[i][k] * bv[k]; a[i][k] *= gv[k]; t1 += a[i][k]; }
        }
        t1 = wave_sum(t1); t2 = wave_sum(t2);
        if (lane == 0) { cu1[row] = t1; cu2[row] = t2; }
    }
    float m = 0.f;
#pragma unroll
    for (int i = 0; i < 4; ++i) m = fmaxf(fmaxf(fmaxf(fabsf(a[i][0]), fabsf(a[i][1])), fmaxf(fabsf(a[i][2]), fabsf(a[i][3]))), m);
#pragma unroll
    for (int o = 32; o > 0; o >>= 1) m = fmaxf(m, __shfl_xor(m, o));
    const float qmax = as_int8 ? 127.f : 440.f;
    const float sc = m > 0.f ? qmax / m : 1.f;
    u32x4 w;
#pragma unroll
    for (int i = 0; i < 4; ++i) {
        if (as_int8) w[i] = pack_i8x4(a[i][0] * sc, a[i][1] * sc, a[i][2] * sc, a[i][3] * sc);
        else {
            int v = 0;
            v = __builtin_amdgcn_cvt_pk_fp8_f32(a[i][0] * sc, a[i][1] * sc, v, false);
            v = __builtin_amdgcn_cvt_pk_fp8_f32(a[i][2] * sc, a[i][3] * sc, v, true);
            w[i] = (unsigned)v;
        }
    }
#if PEER_SLICED
    *(u32x4*)(dst + (size_t)(lane >> 3) * (16384 * 128) + (size_t)row * 128 + (lane & 7) * 16) = w;
#else
    *(u32x4*)(dst + (size_t)row * 1024 + 16 * lane) = w;
#endif
    if (lane == 0) inv[row] = m > 0.f ? m / qmax : 1.f;
}
#define G8_LOAD(R, tab, idreg, k0) do { _Pragma("unroll") for (int j_ = 0; j_ < 16; ++j_) { \
        const int id_ = __builtin_amdgcn_readlane((idreg), (k0) + j_); \
        R[j_] = ((const u32x4*)((tab) + (size_t)id_ * 1024))[lane]; } } while (0)
#define G8_CVT(u_, f_) do { const f32x2_t lo_ = __builtin_amdgcn_cvt_pk_f32_fp8((int)(u_), false), hi_ = __builtin_amdgcn_cvt_pk_f32_fp8((int)(u_), true); \
        f_[0] = lo_.x; f_[1] = lo_.y; f_[2] = hi_.x; f_[3] = hi_.y; } while (0)
#define G8_DOT(R, p) do { _Pragma("unroll") for (int j_ = 0; j_ < 16; ++j_) { float f_[4]; float d0_, d1_; \
        G8_CVT(R[j_].x, f_); d0_ = f_[0] * xv[0]; d1_ = f_[1] * xv[1]; d0_ = fmaf(f_[2], xv[2], d0_); d1_ = fmaf(f_[3], xv[3], d1_); \
        G8_CVT(R[j_].y, f_); d0_ = fmaf(f_[0], xv[4], d0_); d1_ = fmaf(f_[1], xv[5], d1_); d0_ = fmaf(f_[2], xv[6], d0_); d1_ = fmaf(f_[3], xv[7], d1_); \
        G8_CVT(R[j_].z, f_); d0_ = fmaf(f_[0], xv[8], d0_); d1_ = fmaf(f_[1], xv[9], d1_); d0_ = fmaf(f_[2], xv[10], d0_); d1_ = fmaf(f_[3], xv[11], d1_); \
        G8_CVT(R[j_].w, f_); d0_ = fmaf(f_[0], xv[12], d0_); d1_ = fmaf(f_[1], xv[13], d1_); d0_ = fmaf(f_[2], xv[14], d0_); d1_ = fmaf(f_[3], xv[15], d1_); \
        p[j_] = d0_ + d1_; } } while (0)
#define G8_ACC(R, wreg, k0) do { _Pragma("unroll") for (int j_ = 0; j_ < 16; ++j_) { float f_[4]; \
        const float w_ = __uint_as_float((unsigned)__builtin_amdgcn_readlane((int)__float_as_uint(wreg), (k0) + j_)); \
        G8_CVT(R[j_].x, f_); y[0] = fmaf(w_, f_[0], y[0]); y[1] = fmaf(w_, f_[1], y[1]); y[2] = fmaf(w_, f_[2], y[2]); y[3] = fmaf(w_, f_[3], y[3]); \
        G8_CVT(R[j_].y, f_); y[4] = fmaf(w_, f_[0], y[4]); y[5] = fmaf(w_, f_[1], y[5]); y[6] = fmaf(w_, f_[2], y[6]); y[7] = fmaf(w_, f_[3], y[7]); \
        G8_CVT(R[j_].z, f_); y[8] = fmaf(w_, f_[0], y[8]); y[9] = fmaf(w_, f_[1], y[9]); y[10] = fmaf(w_, f_[2], y[10]); y[11] = fmaf(w_, f_[3], y[11]); \
        G8_CVT(R[j_].w, f_); y[12] = fmaf(w_, f_[0], y[12]); y[13] = fmaf(w_, f_[1], y[13]); y[14] = fmaf(w_, f_[2], y[14]); y[15] = fmaf(w_, f_[3], y[15]); } } while (0)

#define LR_XC    0
#define LR_PV    (32 * 1040)
#define LR_PS    (LR_PV + 32 * 512 * 4)
#define LR_END   (LR_PS + 1024)
#ifndef PF_LRU_F
#define PF_LRU_F 1
#endif
#ifndef PF_LRU_T
#define PF_LRU_T 1
#endif
#ifndef PF_HG2
#define PF_HG2 1
#endif
#ifndef PF_HG4
#define PF_HG4 1
#endif
struct LruConst { float cw0, cw1, cw2, cw3, cbv, bav, bxv, sp8, gv; };
__device__ __forceinline__ void lru2_const(LruConst& K, const float* __restrict__ cw, const float* __restrict__ cb, const float* __restrict__ ba, const float* __restrict__ bx,
                                           const float* __restrict__ lam, const float* __restrict__ ng) {
    const int c = opaque_tid();
    K.cw0 = cw[c]; K.cw1 = cw[512 + c]; K.cw2 = cw[1024 + c]; K.cw3 = cw[1536 + c]; K.cbv = cb[c];
    K.bav = ba[c]; K.bxv = bx[c]; K.sp8 = -8.f * log1pf(expf(-lam[c])); K.gv = ng[c];
}
template <bool FINAL> struct LruRegs { bf16_t xr[35]; bf16_t gr[FINAL ? 32 : 1]; float H; };
template <bool FINAL>
__device__ __forceinline__ void lru2_load(int unit, const bf16_t* __restrict__ h, const float* __restrict__ hseg, LruRegs<FINAL>& R) {
    const int b = unit >> 8, sg = unit & 255;
    const int c = opaque_tid();
    const size_t t0 = (size_t)b * SEQ + sg * 32;
#pragma unroll
    for (int k = 0; k < 35; ++k) R.xr[k] = (sg > 0 || k >= 3) ? h[(t0 + k - 3) * INW + c] : (bf16_t)0;
    if (FINAL) {
#pragma unroll
        for (int t = 0; t < 32; ++t) R.gr[t] = h[(t0 + t) * INW + 512 + c];
        R.H = hseg[(size_t)unit * 512 + c];
    } else {
        R.H = 0.f;
    }
}
__device__ __forceinline__ void lru2_front(const bf16_t (&xr)[35], const LruConst& K, const bf16_t* __restrict__ wT  , unsigned char* lds) {
    const int c = opaque_tid(), hh = c >> 6, lane = c & 63;
    __syncthreads();
#pragma unroll
    for (int t = 0; t < 32; ++t) {
        const float xc = K.cbv + K.cw0 * bf2f(xr[t]) + K.cw1 * bf2f(xr[t + 1]) + K.cw2 * bf2f(xr[t + 2]) + K.cw3 * bf2f(xr[t + 3]);
        *(bf16_t*)(lds + LR_XC + t * 1040 + c * 2) = f2bf(xc);
    }
    {
        f32x16 acc[2][2];
#pragma unroll
        for (int g = 0; g < 2; ++g)
#pragma unroll
            for (int nt = 0; nt < 2; ++nt)
#pragma unroll
                for (int r = 0; r < 16; ++r) acc[g][nt][r] = 0.f;
#pragma unroll
        for (int ks = 0; ks < 4; ++ks) {
            const bf16x8_t a = *(const bf16x8_t*)(lds + LR_XC + (lane & 31) * 1040 + (hh * 64 + ks * 16 + 8 * (lane >> 5)) * 2);
#pragma unroll
            for (int g = 0; g < 2; ++g)
#pragma unroll
                for (int nt = 0; nt < 2; ++nt) {
                    const bf16x8_t bw = *(const bf16x8_t*)(wT + ((size_t)(g * 8 + hh) * 64 + nt * 32 + (lane & 31)) * 64 + ks * 16 + 8 * (lane >> 5));
                    acc[g][nt] = __builtin_amdgcn_mfma_f32_32x32x16_bf16(a, bw, acc[g][nt], 0, 0, 0);
                }
        }
#pragma unroll
        for (int nt = 0; nt < 2; ++nt)
#pragma unroll
            for (int r = 0; r < 16; ++r) {
                const int t = (r & 3) + 8 * (r >> 2) + 4 * (lane >> 5);
                *(unsigned*)(lds + LR_PV + (t * 512 + hh * 64 + nt * 32 + (lane & 31)) * 4) = pack2bf(acc[0][nt][r], acc[1][nt][r]);
            }
    }
}
template <bool FINAL>
__device__ __forceinline__ void lru2_back(int unit, const LruRegs<FINAL>& R, const LruConst& K, float* __restrict__ aseg, float* __restrict__ hseg, bf16_t* __restrict__ mixin, unsigned char* lds) {
    const int b = unit >> 8, sg = unit & 255;
    const int c = opaque_tid(), hh = c >> 6, lane = c & 63;
    const size_t t0 = (size_t)b * SEQ + sg * 32;
    float H = R.H;
    float A = 1.f;
    float* ps = (float*)(lds + LR_PS);
#pragma unroll
    for (int tb = 0; tb < 32; tb += 16) {
        float sq[16];
#pragma unroll
        for (int k = 0; k < 16; ++k) {
            const int t = tb + k;
            const unsigned pre = *(const unsigned*)(lds + LR_PV + (t * 512 + c) * 4);
            const float xc = bf2f(*(const bf16_t*)(lds + LR_XC + t * 1040 + c * 2));
            const float r = sigmoidf_(__uint_as_float(pre << 16) + K.bav), ig = sigmoidf_(__uint_as_float(pre & 0xffff0000u) + K.bxv);
            const float a = __expf(K.sp8 * r);
            const float u = sqrtf(fmaxf(1.f - a * a, 0.f)) * (ig * xc);
            H = fmaf(a, H, u);
            if (FINAL) {
                const float gt = bf2f(R.gr[t]);
                const float v = H * gt * sigmoidf_(1.5957691216057308f * (gt + 0.044715f * gt * gt * gt));
                *(float*)(lds + LR_PV + (t * 512 + c) * 4) = v;
                sq[k] = v * v;
            } else {
                A *= a;
            }
        }
        if (FINAL) {
            const float tot = tr_reduce16(sq, lane & 15);
            if (lane < 16) ps[(tb + lane) * 8 + hh] = tot;
        }
    }
    if (FINAL) {
        __syncthreads();
#pragma unroll 4
        for (int t = 0; t < 32; ++t) {
            const f32x4 p0 = *(const f32x4*)(ps + t * 8), p1 = *(const f32x4*)(ps + t * 8 + 4);
            const float tot = (p0[0] + p0[1]) + (p0[2] + p0[3]) + (p1[0] + p1[1]) + (p1[2] + p1[3]);
            const float rs = rsqrtf(tot * (1.f / 512.f) + 1e-5f);
            mixin[(t0 + t) * DM + c] = f2bf(*(const float*)(lds + LR_PV + (t * 512 + c) * 4) * rs * K.gv);
        }
    } else {
        aseg[(size_t)unit * 512 + c] = A;
        hseg[(size_t)unit * 512 + c] = H;
    }
}
template <bool FINAL>
__device__ __forceinline__ void lru2_units(int bid, int G, const bf16_t* __restrict__ h, const float* __restrict__ cw, const float* __restrict__ cb, const bf16_t* __restrict__ wT,
                                           const float* __restrict__ ba, const float* __restrict__ bx, const float* __restrict__ lam, const float* __restrict__ ng,
                                           float* __restrict__ aseg, float* __restrict__ hseg, bf16_t* __restrict__ mixin, unsigned char* lds) {
    if (bid >= 1024) return;
    LruConst K; lru2_const(K, cw, cb, ba, bx, lam, ng);
    LruRegs<FINAL> cur, nxt;
    lru2_load<FINAL>(bid, h, hseg, cur);
#pragma unroll 1
    for (int u = bid; u < 1024; u += G) {
        if (!(FINAL ? PF_LRU_T : PF_LRU_F) && u != bid) lru2_load<FINAL>(u, h, hseg, cur);
        lru2_front(cur.xr, K, wT, lds);
        if ((FINAL ? PF_LRU_T : PF_LRU_F) && u + G < 1024) lru2_load<FINAL>(u + G, h, hseg, nxt);
        lru2_back<FINAL>(u, cur, K, aseg, hseg, mixin, lds);
        if (FINAL ? PF_LRU_T : PF_LRU_F) cur = nxt;
    }
}
__device__ void lru2_carry(int vb, int tid, const float* __restrict__ aseg, float* __restrict__ hseg) {
    const int i = vb * 256 + tid;
    const int b = i >> 9, c = i & 511;
    float Hc = 0.f;
    for (int s0 = 0; s0 < 256; s0 += 8) {
        float av[8], hv[8];
#pragma unroll
        for (int k = 0; k < 8; ++k) { const size_t o = ((size_t)(b * 256 + s0 + k)) * 512 + c; av[k] = aseg[o]; hv[k] = hseg[o]; }
#pragma unroll
        for (int k = 0; k < 8; ++k) { const size_t o = ((size_t)(b * 256 + s0 + k)) * 512 + c; hseg[o] = Hc; Hc = fmaf(av[k], Hc, hv[k]); }
    }
}

struct EpiZ {
    static constexpr bool PERM = false, AFTER_DRAIN = false;
    bf16_t* Zb; const float* X; float* pstat; float alpha;
    __device__ __forceinline__ void operator()(const pg8::f32x4 (&acc)[2][2][4][2], const pg8::Unit& u, int wr, int wc, int fr, int fq) const {
        const int row0 = u.pm * pg8::BM + wr * 64 + fr, col0 = u.pn * pg8::BM + wc * 32 + 4 * fq;
#pragma unroll
        for (int ai = 0; ai < 2; ++ai)
#pragma unroll
            for (int m = 0; m < 4; ++m) {
                const int row = row0 + ai * pg8::HALF + m * 16;
                const size_t ro = (size_t)row * DM + col0;
                float s1 = 0.f, s2 = 0.f;
#pragma unroll
                for (int bj = 0; bj < 2; ++bj)
#pragma unroll
                    for (int n = 0; n < 2; ++n) {
                        const pg8::f32x4 xv = *(const pg8::f32x4*)(X + ro + bj * pg8::HALF + n * 16);
                        const pg8::f32x4 v = acc[ai][bj][m][n] + xv * alpha;
                        uint2 pk; pk.x = pack2bf(v[0], v[1]); pk.y = pack2bf(v[2], v[3]);
                        *(uint2*)(Zb + ro + bj * pg8::HALF + n * 16) = pk;
                        s1 += (v[0] + v[1]) + (v[2] + v[3]);
                        s2 += (v[0] * v[0] + v[1] * v[1]) + (v[2] * v[2] + v[3] * v[3]);
                    }
                s1 = xrow16_sum(s1); s2 = xrow16_sum(s2);
                if (fq == 0) { float2 st; st.x = s1; st.y = s2; *(float2*)(pstat + ((size_t)row * 16 + u.pn * 4 + wc) * 2) = st; }
            }
    }
};
struct EpiQ {
    static constexpr bool PERM = true, AFTER_DRAIN = false;
    bf16_t* O; int ldc; const float* stats; const float* c1; const float* c2;
    __device__ __forceinline__ void operator()(const pg8::f32x4 (&acc)[2][2][4][2], const pg8::Unit& u, int wr, int wc, int fr, int fq) const {
        const int row0 = u.pm * pg8::BM + wr * 64 + fr;
        const int col0 = u.pn * pg8::BM + wc * 32 + 8 * fq;
        pg8::f32x4 k1[2][2], k2[2][2];
#pragma unroll
        for (int bj = 0; bj < 2; ++bj)
#pragma unroll
            for (int n = 0; n < 2; ++n) { k1[bj][n] = *(const pg8::f32x4*)(c1 + col0 + bj * pg8::HALF + 4 * n); k2[bj][n] = *(const pg8::f32x4*)(c2 + col0 + bj * pg8::HALF + 4 * n); }
#pragma unroll
        for (int ai = 0; ai < 2; ++ai)
#pragma unroll
            for (int m = 0; m < 4; ++m) {
                const int row = row0 + ai * pg8::HALF + m * 16;
                const float2 st = *(const float2*)(stats + (size_t)row * 2);
                bf16_t* rowp = O + (size_t)row * ldc + col0;
#pragma unroll
                for (int bj = 0; bj < 2; ++bj) {
                    const pg8::f32x4 v0 = (acc[ai][bj][m][0] - k1[bj][0] * st.x) * st.y + k2[bj][0];
                    const pg8::f32x4 v1 = (acc[ai][bj][m][1] - k1[bj][1] * st.x) * st.y + k2[bj][1];
                    pg8::u32x4 w; w.x = pg8::cvt_pk_bf16(v0[0], v0[1]); w.y = pg8::cvt_pk_bf16(v0[2], v0[3]); w.z = pg8::cvt_pk_bf16(v1[0], v1[1]); w.w = pg8::cvt_pk_bf16(v1[2], v1[3]);
                    *(pg8::u32x4*)(rowp + bj * pg8::HALF) = w;
                }
            }
    }
};

#define XB_TMO      128
#define XB_XCNT(j)  (256  + 64 * (j))
#define XB_XSUB(j)  (1280 + 64 * (j))
#define XB_XGEN(j)  (2304 + 64 * (j))
#define XB_TOP      3328
#define XB_TOPGEN   3392
#define XCD_BAR_WORDS 3456
#define XB_SPIN_CAP (1u << 18)

__device__ __forceinline__ unsigned xb_ld(unsigned* p)              { return __hip_atomic_load(p, __ATOMIC_RELAXED, __HIP_MEMORY_SCOPE_AGENT); }
__device__ __forceinline__ unsigned xb_add(unsigned* p, unsigned v) { return __hip_atomic_fetch_add(p, v, __ATOMIC_RELAXED, __HIP_MEMORY_SCOPE_AGENT); }
__device__ __forceinline__ unsigned xb_xcc_id() { return (unsigned)__builtin_amdgcn_s_getreg((3 << 11) | 20) & 0xFu; }
#define XB_SPIN(cond, bar) do { unsigned _sp = 0; while (cond) { __builtin_amdgcn_s_sleep(1); \
    if ((++_sp & 255u) == 0u) { if (xb_ld(&(bar)[XB_TMO])) break; if (_sp > XB_SPIN_CAP) { atomicAdd(&(bar)[XB_TMO], 1u); break; } } } } while (0)

struct XcdBarrier {
    unsigned* bar; unsigned x;
    volatile LAS unsigned* st;
};

__device__ __forceinline__ XcdBarrier xcd_barrier_post(unsigned* bar, volatile LAS unsigned* st) {
    XcdBarrier b; b.bar = bar; b.x = xb_xcc_id(); b.st = st;
    if (threadIdx.x == 0) (void)xb_add(&bar[XB_XCNT(b.x)], 1u);
    return b;
}
__device__ __forceinline__ void xcd_barrier_complete(unsigned* bar, unsigned x, unsigned& nloc, unsigned& nx) {
    const unsigned G = gridDim.x * gridDim.y * gridDim.z;
    unsigned sum, cnt, mine, sp = 0u;
    for (;;) {
        sum = 0u; cnt = 0u; mine = 0u;
#pragma unroll
        for (unsigned j = 0; j < 16; ++j) { const unsigned c = xb_ld(&bar[XB_XCNT(j)]); sum += c; cnt += (c > 0u) ? 1u : 0u; mine = (j == x) ? c : mine; }
        if (sum == G) break;
        __builtin_amdgcn_s_sleep(1);
        if ((++sp & 255u) == 0u) { if (xb_ld(&bar[XB_TMO])) break; if (sp > XB_SPIN_CAP) { atomicAdd(&bar[XB_TMO], 1u); break; } }
    }
    nloc = mine > 0u ? mine : 1u; nx = cnt > 0u ? cnt : 1u;
}

__device__ __forceinline__ void xcd_barrier(const XcdBarrier& b) {
    asm volatile("s_waitcnt vmcnt(0)" ::: "memory");
    __syncthreads();
    if (threadIdx.x == 0) {
        unsigned* bar = b.bar;
        __builtin_amdgcn_s_waitcnt(0);
        unsigned nloc = b.st[0], nx = b.st[1];
        if (nloc == 0u) { xcd_barrier_complete(bar, b.x, nloc, nx); b.st[0] = nloc; b.st[1] = nx; }
        const unsigned old = xb_add(&bar[XB_XSUB(b.x)], 1u);
        const unsigned gen = old / nloc;
        if (old + 1u == (gen + 1u) * nloc) {
            __builtin_amdgcn_fence(__ATOMIC_RELEASE, "agent");
            asm volatile("s_waitcnt vmcnt(0)" ::: "memory");
            const unsigned og = xb_add(&bar[XB_TOP], 1u);
            const unsigned tg = og / nx;
            if (og + 1u == (tg + 1u) * nx) xb_add(&bar[XB_TOPGEN], 1u);
            else XB_SPIN(xb_ld(&bar[XB_TOPGEN]) == tg, bar);
            __builtin_amdgcn_fence(__ATOMIC_ACQUIRE, "agent");
            xb_add(&bar[XB_XGEN(b.x)], 1u);
            asm volatile("s_waitcnt vmcnt(0)" ::: "memory");
        } else {
            XB_SPIN(xb_ld(&bar[XB_XGEN(b.x)]) == gen, bar);
            __builtin_amdgcn_fence(__ATOMIC_ACQUIRE, "agent");
            asm volatile("s_waitcnt vmcnt(0)" ::: "memory");
        }
    }
    __syncthreads();
}


#define SL_TOKB 512
#define SL_NITEM (T_TOK / SL_TOKB)
__device__ __forceinline__ bool sl_next(unsigned* qw, int& s, int& tried, int& tb, volatile LAS unsigned* bc) {
    for (;;) {
        if (tried >= 8) return false;
        __syncthreads();
        if (threadIdx.x == 0) bc[0] = __hip_atomic_fetch_add(&qw[s], 1u, __ATOMIC_RELAXED, __HIP_MEMORY_SCOPE_AGENT);
        __syncthreads();
        const unsigned v = bc[0];
        if (v < (unsigned)SL_NITEM) { tb = (int)v; return true; }
        s = (s + 1) & 7; ++tried;
    }
}
template <int CTRL> __device__ __forceinline__ int dppi(int x) { return __builtin_amdgcn_mov_dpp(x, CTRL, 0xf, 0xf, true); }
#define SL_ISSUE(R, IA, IB) do { _Pragma("unroll") for (int i_ = 0; i_ < 16; ++i_) { \
        const int id_ = __shfl((i_ < 8) ? (IA) : (IB), (lane & ~7) | (i_ & 7)); \
        R[i_] = *(const u32x4*)(tabs + ((unsigned)id_ * 128u + coff)); } } while (0)
#define SL_META(T_, IA, IB, WA, WB, XV) do { const size_t o_ = (size_t)(T_) * 128 + 16 * g + ci; IA = idx[o_]; IB = idx[o_ + 8]; \
        if (IS_V) { WA = aux[o_]; WB = aux[o_ + 8]; } \
        else { XV[0] = __builtin_bit_cast(f32x4, *(const u32x4*)((const unsigned char*)zbf + (size_t)(T_) * DM + s * 128 + ci * 16)); } } while (0)
template <bool IS_V>
__device__ __forceinline__ void sl_compute(const u32x4 (&R)[16], int t, int s, int lane, int g, int ci, float wa, float wb, const f32x4 (&xq)[4], float* __restrict__ outp) {
    if (!IS_V) {
        const int zq0 = (int)__float_as_uint(xq[0][0]), zq1 = (int)__float_as_uint(xq[0][1]), zq2 = (int)__float_as_uint(xq[0][2]), zq3 = (int)__float_as_uint(xq[0][3]);
        float pr[16];
#pragma unroll
        for (int i = 0; i < 16; ++i) {
            int acc = __builtin_amdgcn_sdot4((int)R[i].x, zq0, 0, false);
            acc = __builtin_amdgcn_sdot4((int)R[i].y, zq1, acc, false);
            acc = __builtin_amdgcn_sdot4((int)R[i].z, zq2, acc, false);
            acc = __builtin_amdgcn_sdot4((int)R[i].w, zq3, acc, false);
            pr[i] = (float)acc;
        }
#define DPP_ADD(dst, x, CTRLSTR) asm volatile("s_nop 1\n\tv_add_f32_dpp %0, %1, %1 " CTRLSTR " row_mask:0xf bank_mask:0xf bound_ctrl:1" : "=&v"(dst) : "v"(x))
#define TR8_STEP(HALF, CTRLSTR, BIT) _Pragma("unroll") for (int h_ = 0; h_ < (HALF); ++h_) { \
            const float lo_ = pr[h_], hi_ = pr[h_ + (HALF)]; float t1_, t2_; DPP_ADD(t1_, lo_, CTRLSTR); DPP_ADD(t2_, hi_, CTRLSTR); \
            pr[h_] = (ci & (BIT)) ? t2_ : t1_; }
        TR8_STEP(8, "row_half_mirror", 4) TR8_STEP(4, "quad_perm:[2,3,0,1]", 2) TR8_STEP(2, "quad_perm:[1,0,3,2]", 1)
#undef TR8_STEP
#undef DPP_ADD
        *(unsigned*)((bf16_t*)outp + ((size_t)s * T_TOK + t) * 128 + 16 * g + 8 * ((ci >> 2) & 1) + 4 * ((ci >> 1) & 1) + 2 * (ci & 1)) = pack2bf(pr[0], pr[1]);
    } else {
        f32x2_t y2[8];
#pragma unroll
        for (int i = 0; i < 8; ++i) y2[i] = (f32x2_t){0.f, 0.f};
#pragma unroll
        for (int i = 0; i < 16; ++i) {
            const float w_ = __shfl((i < 8) ? wa : wb, (lane & ~7) | (i & 7));
            const f32x2_t w2 = {w_, w_};
            y2[0] = __builtin_amdgcn_cvt_pk_f32_fp8((int)R[i].x, false) * w2 + y2[0];
            y2[1] = __builtin_amdgcn_cvt_pk_f32_fp8((int)R[i].x, true) * w2 + y2[1];
            y2[2] = __builtin_amdgcn_cvt_pk_f32_fp8((int)R[i].y, false) * w2 + y2[2];
            y2[3] = __builtin_amdgcn_cvt_pk_f32_fp8((int)R[i].y, true) * w2 + y2[3];
            y2[4] = __builtin_amdgcn_cvt_pk_f32_fp8((int)R[i].z, false) * w2 + y2[4];
            y2[5] = __builtin_amdgcn_cvt_pk_f32_fp8((int)R[i].z, true) * w2 + y2[5];
            y2[6] = __builtin_amdgcn_cvt_pk_f32_fp8((int)R[i].w, false) * w2 + y2[6];
            y2[7] = __builtin_amdgcn_cvt_pk_f32_fp8((int)R[i].w, true) * w2 + y2[7];
        }
        float y[16];
#pragma unroll
        for (int i = 0; i < 8; ++i) { y[2 * i] = y2[i].x; y[2 * i + 1] = y2[i].y; }
#pragma unroll
        for (int h = 0; h < 8; ++h) {
            const float lo_ = y[h], hi_ = y[h + 8]; const float t1_ = lo_ + dppf<DPP_XOR8>(lo_), t2_ = hi_ + dppf<DPP_XOR8>(hi_);
            y[h] = (lane & 8) ? t2_ : t1_;
        }
#pragma unroll
        for (int h = 0; h < 4; ++h) {
            auto sw = __builtin_amdgcn_permlane16_swap(__float_as_uint(y[h]), __float_as_uint(y[h + 4]), false, false);
            y[h] = __uint_as_float(sw[0]) + __uint_as_float(sw[1]);
        }
#pragma unroll
        for (int h = 0; h < 2; ++h) {
            auto sw = __builtin_amdgcn_permlane32_swap(__float_as_uint(y[h]), __float_as_uint(y[h + 2]), false, false);
            y[h] = __uint_as_float(sw[0]) + __uint_as_float(sw[1]);
        }
        *(unsigned*)((bf16_t*)outp + (size_t)t * DM + s * 128 + ci * 16 + 8 * ((lane >> 3) & 1) + 4 * ((lane >> 4) & 1) + 2 * ((lane >> 5) & 1)) = pack2bf(y[0], y[1]);
    }
}
template <bool IS_V>
__device__ void slice_phase(const float* __restrict__ aux, const bf16_t* __restrict__ zbf, const int* __restrict__ idx, const unsigned char* __restrict__ tab8s, float* __restrict__ outp, unsigned* qw, unsigned char* lds) {
    const int tx = opaque_tid();
    const int lane = tx & 63, w = tx >> 6;
    const int g = lane >> 3, ci = lane & 7;
    constexpr int NT = SL_TOKB / 8;
    volatile LAS unsigned* bc = (volatile LAS unsigned*)(lds + LDS_BYTES - 32);
    int s = (int)xb_xcc_id() & 7, tried = 0, tb = 0;
    while (sl_next(qw, s, tried, tb, bc)) {
        const unsigned char* tabs = tab8s + (size_t)s * (16384 * 128);
        const unsigned coff = (unsigned)ci * 16u;
        const int tbase = tb * SL_TOKB + w * NT;
        u32x4 RA[16], RB[16];
        int ia0, ib0, ia1, ib1; float wa0 = 0.f, wb0 = 0.f, wa1 = 0.f, wb1 = 0.f; f32x4 xq0[4], xq1[4];
        SL_META(tbase, ia0, ib0, wa0, wb0, xq0);
        SL_META(tbase + 1, ia1, ib1, wa1, wb1, xq1);
        SL_ISSUE(RA, ia0, ib0);
#pragma unroll 2
        for (int k = 0; k < NT; k += 2) {
            SL_ISSUE(RB, ia1, ib1);
            const float cwa = wa0, cwb = wb0; f32x4 cx[4];
#pragma unroll
            for (int i = 0; i < 4; ++i) cx[i] = xq0[i];
            if (k + 2 < NT) SL_META(tbase + k + 2, ia0, ib0, wa0, wb0, xq0);
            sl_compute<IS_V>(RA, tbase + k, s, lane, g, ci, cwa, cwb, cx, outp);
            if (k + 2 < NT) SL_ISSUE(RA, ia0, ib0);
            const float dwa = wa1, dwb = wb1; f32x4 dx[4];
#pragma unroll
            for (int i = 0; i < 4; ++i) dx[i] = xq1[i];
            if (k + 3 < NT) SL_META(tbase + k + 3, ia1, ib1, wa1, wb1, xq1);
            sl_compute<IS_V>(RB, tbase + k + 1, s, lane, g, ci, dwa, dwb, dx, outp);
        }
    }
}
__device__ void slice_combine_phase(const float* __restrict__ pd, const int* __restrict__ idx, float* __restrict__ gatew, const float* __restrict__ iu, const float* __restrict__ iv,
                                    const float* __restrict__ stats, const float* __restrict__ cu1, const float* __restrict__ cu2, const float* __restrict__ zsc) {
    for (size_t i = (size_t)blockIdx.x * NTHR + threadIdx.x; i < (size_t)T_TOK * 128; i += (size_t)gridDim.x * NTHR) {
        float sacc = 0.f;
#pragma unroll
        for (int s = 0; s < 8; ++s) sacc += bf2f(((const bf16_t*)pd)[(size_t)s * T_TOK * 128 + i]);
        const int id = idx[i];
        const float2 st = *(const float2*)(stats + (i >> 7) * 2);
        gatew[i] = gelu_as(st.y * (sacc * (iu[id] * zsc[i >> 7]) - st.x * cu1[id]) + cu2[id]) * gatew[i] * iv[id];
    }
}
__device__ void ln2_phase(float* __restrict__ x1io, const bf16_t* __restrict__ zbf, const float* __restrict__ ysl, const float* __restrict__ g, const float* __restrict__ bb,
                          const float* __restrict__ stats, const float* __restrict__ g1, const float* __restrict__ b1) {
    const int tx = opaque_tid();
    const int lane = tx & 63;
    const int gw = blockIdx.x * (NTHR / 64) + (tx >> 6);
    const int nw = gridDim.x * (NTHR / 64);
    for (int t = gw; t < T_TOK; t += nw) {
        float* xr = x1io + (size_t)t * DM + 16 * lane;
        const bf16_t* yr = (const bf16_t*)ysl + (size_t)t * DM + 16 * lane;
        float v[16];
        const float2 st = *(const float2*)(stats + (size_t)t * 2);
#pragma unroll
        for (int i = 0; i < 4; ++i) {
            int off1 = 16 * lane + 4 * i;
            asm volatile("" : "+v"(off1));
            const uint2 zp = *(const uint2*)(zbf + (size_t)t * DM + 16 * lane + 4 * i);
            const f32x4 a = {__uint_as_float(zp.x << 16), __uint_as_float(zp.x & 0xffff0000u), __uint_as_float(zp.y << 16), __uint_as_float(zp.y & 0xffff0000u)};
            const uint2 yp = *(const uint2*)(yr + 4 * i);
            const f32x4 y4 = {__uint_as_float(yp.x << 16), __uint_as_float(yp.x & 0xffff0000u), __uint_as_float(yp.y << 16), __uint_as_float(yp.y & 0xffff0000u)};
            const f32x4 g14 = *(const f32x4*)(g1 + off1), b14 = *(const f32x4*)(b1 + off1);
#pragma unroll
            for (int k = 0; k < 4; ++k) v[4 * i + k] = ALPHA * ((a[k] - st.x) * st.y * g14[k] + b14[k]) + y4[k];
        }
        float sm = 0.f;
#pragma unroll
        for (int i = 0; i < 16; ++i) sm += v[i];
        const float mu = wave_sum(sm) * (1.f / 1024.f);
        float qq = 0.f;
#pragma unroll
        for (int i = 0; i < 16; ++i) { const float d = v[i] - mu; qq += d * d; }
        const float rs = rsqrtf(wave_sum(qq) * (1.f / 1024.f) + 1e-5f);
#pragma unroll
        for (int i = 0; i < 4; ++i) {
            int off = 16 * lane + 4 * i;
            asm volatile("" : "+v"(off));
            const f32x4 gv = *(const f32x4*)(g + off), bv = *(const f32x4*)(bb + off);
            f32x4 o;
#pragma unroll
            for (int k = 0; k < 4; ++k) o[k] = (v[4 * i + k] - mu) * rs * gv[k] + bv[k];
            *(f32x4*)(xr + 4 * i) = o;
        }
    }
}

struct Params {
    const float* in[21];
    float* out;
    char* ws;
    int nrep_gather;
    int probe;
};

#define WS_XB      0
#define WS_WIN     64
#define WS_WOUT    70
#define WS_WQ      72
#define WS_SK      76
#define WS_UT      80
#define WS_VT      112
#define WS_H       144
#define WS_X1B     272
#define WS_XC      340
#define WS_ITOP    372
#define WS_IDX     404
#define WS_GATE    420
#define WS_KV      436
#define WS_GAM     500
#define WS_ASEG    501
#define WS_HSEG    503
#define WS_DBG     505
#define WS_BAR     506
#define WS_LRUW    507
#define WS_PSTAT   508
#define WS_END     512
#ifndef DEBUG_HG
#define DEBUG_HG 0
#endif

__global__ void __launch_bounds__(NTHR, 2) mega(Params p) {
    extern __shared__ __attribute__((aligned(16))) unsigned char lds[];
    if (threadIdx.x < 4) ((volatile LAS unsigned*)(lds + LDS_BYTES - 16))[threadIdx.x] = 0u;
    __syncthreads();
    const XcdBarrier gbar = xcd_barrier_post((unsigned*)(p.ws + (size_t)WS_BAR * 1024 * 1024), (volatile LAS unsigned*)(lds + LDS_BYTES - 16));
    const float* x = p.in[0];
    const float* w_in = p.in[1];
    const float* conv_w = p.in[2];
    const float* conv_b = p.in[3];
    const float* lru_wa = p.in[4];
    const float* lru_ba = p.in[5];
    const float* lru_wx = p.in[6];
    const float* lru_bx = p.in[7];
    const float* lru_lam = p.in[8];
    const float* lru_ng = p.in[9];
    const float* lbl = p.in[10];
    const float* hg_ng = p.in[11];
    const float* w_out = p.in[12];
    const float* ln1_g = p.in[13];
    const float* ln1_b = p.in[14];
    const float* wq = p.in[15];
    const float* subk = p.in[16];
    const float* ut = p.in[17];
    const float* vt = p.in[18];
    const float* ln2_g = p.in[19];
    const float* ln2_b = p.in[20];
    float* out = p.out;
    char* ws = p.ws;
    const size_t MB = 1024 * 1024;
    bf16_t* xb = (bf16_t*)(ws + WS_XB * MB);
    bf16_t* mixin = (bf16_t*)(ws + WS_XB * MB);
    bf16_t* w_inT = (bf16_t*)(ws + WS_WIN * MB);
    bf16_t* w_outT = (bf16_t*)(ws + WS_WOUT * MB);
    bf16_t* wqT = (bf16_t*)(ws + WS_WQ * MB);
    bf16_t* utb = (bf16_t*)(ws + WS_UT * MB);
    bf16_t* skb = (bf16_t*)(ws + WS_SK * MB);
    unsigned char* u8 = (unsigned char*)(ws + WS_UT * MB);
    unsigned char* v8 = (unsigned char*)(ws + WS_VT * MB);
    float* iu = (float*)(ws + (WS_UT + 16) * MB);
    float* iv = (float*)(ws + (WS_VT + 16) * MB);
    float* cu1 = iu + 16384;
    float* cu2 = iu + 2 * 16384;
    float* qc1 = (float*)(ws + 77 * MB);
    float* qc2 = qc1 + 2048;
    float* stats = (float*)(ws + 77 * MB + 65536);
    float* qc1p = (float*)(ws + 78 * MB);
    float* qc2p = qc1p + 16 * 2048;
    float* pstat = (float*)(ws + (size_t)WS_PSTAT * MB);
    unsigned char* zq = (unsigned char*)(ws + (size_t)WS_XC * MB);
    float* zsc = (float*)(ws + (size_t)(WS_XC + 32) * MB);
    bf16_t* vtb = (bf16_t*)(ws + WS_VT * MB);
    bf16_t* h = (bf16_t*)(ws + WS_H * MB);
    float* z = (float*)(ws + WS_H * MB);
    bf16_t* q = (bf16_t*)(ws + WS_H * MB);
    bf16_t* x1b = (bf16_t*)(ws + WS_X1B * MB);
    float* xc = (float*)(ws + WS_XC * MB);
    float* s_top = (float*)(ws + WS_XC * MB);
    int* i_top = (int*)(ws + WS_ITOP * MB);
    int* idx = (int*)(ws + WS_IDX * MB);
    float* gate = (float*)(ws + WS_GATE * MB);
    bf16_t* kvb = (bf16_t*)(ws + WS_KV * MB);
    float* gam = (float*)(ws + WS_GAM * MB);
    float* dbg = (float*)(ws + WS_DBG * MB);
    float* aseg = (float*)(ws + WS_ASEG * MB);
    float* hseg = (float*)(ws + WS_HSEG * MB);
    bf16_t* lruwT = (bf16_t*)(ws + WS_LRUW * MB);
    bf16_t* mixin2 = (bf16_t*)(ws + WS_XC * MB);
    float* a_arr = out;
    float* u_arr = out + (size_t)T_TOK * 512;
    const int G = gridDim.x, bid = blockIdx.x;
    const int half = threadIdx.x >> 8, tid = threadIdx.x & 255;
    float* smf = (float*)lds;
    if (bid == 0 && threadIdx.x == 0) { dbg[0] = 0.f; dbg[1] = 0.f; }

#define REPEAT(k) _Pragma("unroll 1") for (int rp_ = (p.probe == (k) || ((k) == 4 && p.probe == 9)) ? 1 : 0; rp_ >= 0; --rp_)
    REPEAT(1) {
    for (int u = bid; u < T_TOK * DM / 4096; u += G) cvt_unit(u, x, xb);
    for (int u = bid; u < 64; u += G) cvt_unit(u, subk, skb);
    for (int e = bid * NTHR + threadIdx.x; e < 2 * 8 * 64 * 64; e += G * NTHR) {
        const int i_ = e & 63, j_ = (e >> 6) & 63, hh_ = (e >> 12) & 7, g_ = e >> 15;
        lruwT[e] = f2bf((g_ ? lru_wx : lru_wa)[(hh_ * 64 + i_) * 64 + j_]);
    }
    for (int u = bid; u < 16 * 48 + 16 * 16 + 16 * 32; u += G) {
        if (u < 768) transpose_unit(u, w_in, w_inT, 1024, 3072, smf);
        else if (u < 768 + 256) transpose_unit(u - 768, w_out, w_outT, 1024, 1024, smf);
        else transpose_unit(u - 1024, wq, wqT, 1024, 2048, smf, ln1_g, ln1_b, qc1p, qc2p);
    }
    }
    xcd_barrier(gbar);
    REPEAT(2) {
        pg8::Gemm g{xb, w_inT, T_TOK, INW, DM}; pg8::StaticOrder S; S.init(T_TOK, INW, G, bid);
        EpiBf16 E{h, INW};
        pg8::gemm_phase<EpiBf16, pg8::StaticOrder, false>((PG8_LAS unsigned char*)lds, g, S, E, nullptr);
    }
    xcd_barrier(gbar);
    {
        lru2_units<false>(bid, G, h, conv_w, conv_b, lruwT, lru_ba, lru_bx, lru_lam, lru_ng, aseg, hseg, mixin, lds);
        if (bid < 2048) {
            float lb4[2][4];
            { const int d_ = 2 * (opaque_tid() & 63);
#pragma unroll
              for (int k = 0; k < 4; ++k) { lb4[0][k] = hg_lb(lbl, k * 128 + d_); lb4[1][k] = hg_lb(lbl, k * 128 + d_ + 1); } }
            HgP2Regs cur, nxt;
            hgrn_p2_load(bid, h, cur);
#pragma unroll 1
            for (int u = bid; u < 2048; u += G) {
                if (!PF_HG2 && u != bid) hgrn_p2_load(u, h, cur);
                if (PF_HG2 && u + G < 2048) hgrn_p2_load(u + G, h, nxt);
                hgrn_p2_body(u, cur, lb4, kvb, gam, lds);
                if (PF_HG2) cur = nxt;
            }
        }
    }
    xcd_barrier(gbar);
    if (threadIdx.x < 256) {
        hgrn_scan4(threadIdx.x, kvb, gam);
        if (bid < 8) lru2_carry(bid, threadIdx.x, aseg, hseg);
    } else {
        for (int r = bid * 4 + ((threadIdx.x - 256) >> 6); r < 2 * 16384; r += G * 4) {
            if (r < 16384) quant_row(ut, u8, iu, r, threadIdx.x & 63, ln1_g, ln1_b, cu1, cu2, true); else quant_row(vt, v8, iv, r - 16384, threadIdx.x & 63);
        }
    }
    xcd_barrier(gbar);
    {
        lru2_units<true>(bid, G, h, conv_w, conv_b, lruwT, lru_ba, lru_bx, lru_lam, lru_ng, aseg, hseg, mixin, lds);
        if (bid < 2048) {
            float lb4[2][4], gn4[4];
            { const int d_ = 2 * (opaque_tid() & 63), e_ = (opaque_tid() & 31) + 32 * ((opaque_tid() >> 6) & 3);
#pragma unroll
              for (int k = 0; k < 4; ++k) { lb4[0][k] = hg_lb(lbl, k * 128 + d_); lb4[1][k] = hg_lb(lbl, k * 128 + d_ + 1); gn4[k] = hg_ng[k * 128 + e_]; } }
            HgP4Regs cur, nxt;
            hgrn_p4_load(bid, h, kvb, cur);
#pragma unroll 1
            for (int u = bid; u < 2048; u += G) {
                if (!PF_HG4 && u != bid) hgrn_p4_load(u, h, kvb, cur);
                if (PF_HG4 && u + G < 2048) hgrn_p4_load(u + G, h, kvb, nxt);
                hgrn_p4_body(u, cur, lb4, gn4, mixin, lds);
                if (PF_HG4) cur = nxt;
            }
        }
    }
    xcd_barrier(gbar);
    REPEAT(5) {
        pg8::Gemm g{mixin, w_outT, T_TOK, DM, DM}; pg8::StaticOrder S; S.init(T_TOK, DM, G, bid);
        EpiZ E{x1b, x, pstat, ALPHA};
        pg8::gemm_phase<EpiZ, pg8::StaticOrder, false>((PG8_LAS unsigned char*)lds, g, S, E, nullptr);
    }
    xcd_barrier(gbar);
    for (int n = bid * NTHR + threadIdx.x; n < 2048; n += G * NTHR) {
        float s1 = 0.f, s2 = 0.f;
#pragma unroll
        for (int kt = 0; kt < 16; ++kt) { s1 += qc1p[kt * 2048 + n]; s2 += qc2p[kt * 2048 + n]; }
        qc1[n] = s1; qc2[n] = s2;
    }
    for (int t = bid * (NTHR / 64) + (threadIdx.x >> 6); t < T_TOK; t += G * (NTHR / 64)) {
        const int ln = threadIdx.x & 63;
        const u32x4* zp = (const u32x4*)(x1b + (size_t)t * DM + 16 * ln);
        const u32x4 z0 = zp[0], z1 = zp[1];
        const unsigned zw[8] = {z0.x, z0.y, z0.z, z0.w, z1.x, z1.y, z1.z, z1.w};
        float zf[16]; float m = 0.f;
#pragma unroll
        for (int k = 0; k < 8; ++k) { zf[2 * k] = __uint_as_float(zw[k] << 16); zf[2 * k + 1] = __uint_as_float(zw[k] & 0xffff0000u); m = fmaxf(m, fmaxf(fabsf(zf[2 * k]), fabsf(zf[2 * k + 1]))); }
#pragma unroll
        for (int o = 32; o > 0; o >>= 1) m = fmaxf(m, __shfl_xor(m, o));
        const float sc = m > 0.f ? 127.f / m : 1.f;
        u32x4 wq4;
#pragma unroll
        for (int k = 0; k < 4; ++k) wq4[k] = pack_i8x4(zf[4 * k] * sc, zf[4 * k + 1] * sc, zf[4 * k + 2] * sc, zf[4 * k + 3] * sc);
        *(u32x4*)(zq + (size_t)t * DM + 16 * ln) = wq4;
        if (ln == 0) zsc[t] = m > 0.f ? m / 127.f : 1.f;
    }
    for (int t = bid * NTHR + threadIdx.x; t < T_TOK; t += G * NTHR) {
        const f32x4* pp = (const f32x4*)(pstat + (size_t)t * 32);
        float s1 = 0.f, s2 = 0.f;
#pragma unroll
        for (int i = 0; i < 8; ++i) { const f32x4 v = pp[i]; s1 += v[0] + v[2]; s2 += v[1] + v[3]; }
        const float mu = s1 * (1.f / 1024.f);
        float2 st; st.x = mu; st.y = rsqrtf(fmaxf(s2 * (1.f / 1024.f) - mu * mu, 0.f) + 1e-5f);
        *(float2*)(stats + (size_t)t * 2) = st;
    }
    xcd_barrier(gbar);
    REPEAT(7) {
        pg8::Gemm g{x1b, wqT, T_TOK, 2048, DM}; pg8::StaticOrder S; S.init(T_TOK, 2048, G, bid);
        EpiQ E{q, 2048, stats, qc1, qc2};
        pg8::gemm_phase<EpiQ, pg8::StaticOrder, false>((PG8_LAS unsigned char*)lds, g, S, E, nullptr);
    }
    xcd_barrier(gbar);
    REPEAT(8) topk_phase(q, skb, idx, gate, lds);
    xcd_barrier(gbar);
#if PEER_SLICED
    {
        unsigned* qw = (unsigned*)(p.ws + (size_t)WS_BAR * 1024 * 1024) + XCD_BAR_WORDS;
        float* pd = (float*)(ws + WS_H * MB);
        slice_phase<false>(nullptr, (const bf16_t*)zq, idx, u8, pd, qw, lds);
        xcd_barrier(gbar);
        slice_combine_phase(pd, idx, gate, iu, iv, stats, cu1, cu2, zsc);
        xcd_barrier(gbar);
        slice_phase<true>(gate, nullptr, idx, v8, pd, qw + 8, lds);
        xcd_barrier(gbar);
        ln2_phase(out, x1b, pd, ln2_g, ln2_b, stats, ln1_g, ln1_b);
    }
#else
#pragma unroll 1
    for (int rp = p.nrep_gather; rp >= 0; --rp)
        gather8_phase(out, rp ? (float*)(ws + WS_H * MB) : out, idx, gate, u8, v8, iu, iv, ln2_g, ln2_b);
#endif
}

extern "C" void kernel_launch(void* const* d_in, const int* in_sizes, int n_in, void* d_out, int out_size, void* d_ws, size_t ws_size, hipStream_t stream) {
    static int grid_blocks = 0;
    if (!grid_blocks) {
        int dev = 0, cus = 0, per_cu = 0;
        (void)hipGetDevice(&dev);
        (void)hipDeviceGetAttribute(&cus, hipDeviceAttributeMultiprocessorCount, dev);
        if (hipFuncSetAttribute((const void*)mega, hipFuncAttributeMaxDynamicSharedMemorySize, LDS_BYTES) != hipSuccess) { fprintf(stderr, "hipFuncSetAttribute failed\n"); return; }
        (void)hipOccupancyMaxActiveBlocksPerMultiprocessor(&per_cu, mega, NTHR, LDS_BYTES);
        if (per_cu < 1) { fprintf(stderr, "occupancy query says %d\n", per_cu); return; }
        grid_blocks = cus;
    }
    if (ws_size < (size_t)WS_END * 1024 * 1024 || n_in != 21) { fprintf(stderr, "ws too small %zu or n_in %d\n", ws_size, n_in); return; }
    Params p{};
    for (int i = 0; i < 21; i++) p.in[i] = (const float*)d_in[i];
    p.out = (float*)d_out;
    p.ws = (char*)d_ws;
    p.nrep_gather = PROBE_NREP;
    p.probe = PROBE_PHASE;
    if (hipMemsetAsync((char*)d_ws + (size_t)WS_BAR * 1024 * 1024, 0, (XCD_BAR_WORDS + 16) * 4, stream) != hipSuccess) { fprintf(stderr, "memset of barrier words failed\n"); return; }
    void* args[] = {&p};
    hipError_t e = hipLaunchCooperativeKernel((void*)mega, dim3(grid_blocks), dim3(NTHR), args, LDS_BYTES, stream);
    if (e != hipSuccess) fprintf(stderr, "cooperative launch failed: %s (grid %d)\n", hipGetErrorString(e), grid_blocks);
}
```

```cpp
#include <hip/hip_runtime.h>
#include <hip/hip_cooperative_groups.h>
#include <cstdio>
#include <cstdint>
namespace cg = cooperative_groups;

#ifndef PEER_SLICED
#define PEER_SLICED 1
#endif
#ifndef PROBE_PHASE
#define PROBE_PHASE 0
#endif
#ifndef PROBE_NREP
#define PROBE_NREP 0
#endif
#define T_TOK 32768
#define SEQ 8192
#define DM 1024
#define INW 3072
#define NTHR 512
#define LDS_BYTES (144 * 1024)
#define ALPHA 1.189207115002721f
#define LAS __attribute__((address_space(3)))

namespace pg8 {
#define PG8_LAS __attribute__((address_space(3)))
typedef unsigned short bf16_t;
typedef short bf16x8 __attribute__((ext_vector_type(8)));
typedef float f32x4 __attribute__((ext_vector_type(4)));
typedef unsigned u32x4 __attribute__((ext_vector_type(4)));
constexpr int BM = 256, BK = 64, HALF = 128, HTB = HALF * BK * 2  , STAGE_BYTES = 8 * HTB, NXCD = 8, WGM = 8;

__host__ __device__ __forceinline__ int lds_byte(int r, int c) { const int st = (r >> 4) * 2 + (c >> 5), rr = r & 15, cc = c & 31, ob = rr * 64 + cc * 2; return st * 1024 + (ob ^ (((ob >> 9) & 1) << 5)); }
__host__ __device__ __forceinline__ void stage_rc(int b, int& R, int& C) { const int st = b / 1024, sb = b % 1024, swz = sb ^ (((sb >> 9) & 1) << 5); R = (st >> 1) * 16 + swz / 64; C = (st & 1) * 32 + (swz % 64) / 2; }
__host__ __device__ __forceinline__ int perm32(int rho) { const int n = rho >> 4, i = rho & 15; return 8 * (i >> 2) + 4 * n + (i & 3); }

struct Unit { int pm, pn; };
struct Gemm { const bf16_t* A; const bf16_t* Bt; int M, N, K; };

struct StaticOrder {
    int nM, nN, nwg, G, c;
    __host__ __device__ void init(int M, int N, int G_, int c_) { nM = M / BM; nN = N / BM; nwg = nM * nN; G = G_; c = c_; }
    __host__ __device__ bool next(int i, Unit& u) const {
        const long L = (long)i * G + c; if (L >= nwg) return false;
        int wgid = (int)L; { const int q = nwg / NXCD, r = nwg % NXCD, xcd = wgid % NXCD, off = wgid / NXCD; wgid = (xcd < r ? xcd * (q + 1) : r * (q + 1) + (xcd - r) * q) + off; }
        const int nig = WGM * nN, gid = wgid / nig, fm = gid * WGM, gsz = (nM - fm) < WGM ? (nM - fm) : WGM;
        u.pm = fm + ((wgid % nig) % gsz); u.pn = (wgid % nig) / gsz; return true;
    }
    __device__ __forceinline__ void a_ready(const Unit&) const {}
    __device__ __forceinline__ void done(const Unit&) const {}
};
typedef __bf16 bf16x2c_t __attribute__((ext_vector_type(2))); typedef float f32x2c_t __attribute__((ext_vector_type(2)));
__device__ __forceinline__ unsigned cvt_pk_bf16(float lo, float hi) { return __builtin_bit_cast(unsigned, __builtin_convertvector((f32x2c_t){lo, hi}, bf16x2c_t)); }
typedef float f32x2 __attribute__((ext_vector_type(2)));
template <class Epi, class Sched, bool STAMP = false>
__device__ __forceinline__ void gemm_phase(PG8_LAS unsigned char* lds, const Gemm g, const Sched& S, const Epi& E, unsigned long long* stamps) {
    int tid = threadIdx.x; asm volatile("" : "+v"(tid)); const int wid = __builtin_amdgcn_readfirstlane(tid >> 6), lane = tid & 63, wr = wid >> 2, wc = wid & 3, fr = lane & 15, fq = lane >> 4;
    const int K = g.K, nt = K / BK;
    int ts_lo = 0, ts_hi = 0, nts = 0; const unsigned long long rt_entry = STAMP ? (unsigned long long)wall_clock64() : 0ull;
#define PG8_STAMP() do { if (STAMP && wid == 0 && nts < 64) { const unsigned long long _c = (unsigned long long)clock64(); \
        ts_lo = (lane == nts) ? (int)(unsigned)_c : ts_lo; ts_hi = (lane == nts) ? (int)(unsigned)(_c >> 32) : ts_hi; ++nts; } } while (0)
    PG8_STAMP();
    unsigned voffA[2], voffB[2];
#pragma unroll
    for (int i = 0; i < 2; ++i) { int R, C; stage_rc(tid * 16 + i * 8192, R, C); const int Rb = Epi::PERM ? ((R & ~31) + perm32(R & 31)) : R;
        voffA[i] = (unsigned)(R * K + C) * 2u; voffB[i] = (unsigned)(Rb * K + C) * 2u; }
    const size_t kstep = (size_t)(BK * 2);
    const size_t hstep = (size_t)HALF * K * 2;
    const size_t tstep = 2 * hstep;
    const unsigned ldsw = (unsigned)wid * 1024u;
    const int aoff = lds_byte(wr * 64 + fr, fq * 8), boff = lds_byte(wc * 32 + fr, fq * 8);
#define PG8_SA(b, h) (((b) * 2 + (h)) * HTB)
#define PG8_SB(b, h) ((4 + (b) * 2 + (h)) * HTB)
#define PG8_STAGE(bufoff, gbase, voff) do { _Pragma("unroll") for (int _i = 0; _i < 2; ++_i) \
        __builtin_amdgcn_global_load_lds((const unsigned*)((const char*)(gbase) + (voff)[_i]), (PG8_LAS unsigned*)(lds + (bufoff) + ldsw + _i * 8192), 16, 0, 0); } while (0)
#define PG8_LDA(dst, b, h) do { _Pragma("unroll") for (int m = 0; m < 4; ++m) _Pragma("unroll") for (int k = 0; k < 2; ++k) dst[m][k] = *(const PG8_LAS bf16x8*)(lds + PG8_SA(b, h) + aoff + m * 2048 + k * 1024); } while (0)
#define PG8_LDB(dst, b, h) do { _Pragma("unroll") for (int n = 0; n < 2; ++n) _Pragma("unroll") for (int k = 0; k < 2; ++k) dst[n][k] = *(const PG8_LAS bf16x8*)(lds + PG8_SB(b, h) + boff + n * 2048 + k * 1024); } while (0)
#define PG8_MMA(ai, bj, At, Bt) do { __builtin_amdgcn_s_setprio(1); _Pragma("unroll") for (int m = 0; m < 4; ++m) _Pragma("unroll") for (int n = 0; n < 2; ++n) _Pragma("unroll") for (int k = 0; k < 2; ++k) \
        acc[ai][bj][m][n] = __builtin_amdgcn_mfma_f32_16x16x32_bf16(Bt[n][k], At[m][k], acc[ai][bj][m][n], 0, 0, 0); __builtin_amdgcn_s_setprio(0); } while (0)
#define PG8_WAIT_V(n) asm volatile("s_waitcnt vmcnt(" #n ")" ::: "memory")
#define PG8_WAIT_L(n) asm volatile("s_waitcnt lgkmcnt(" #n ")" ::: "memory")
#define PG8_BAR __builtin_amdgcn_s_barrier()
#define PG8_SCHED __builtin_amdgcn_sched_barrier(0)
    Unit cur, nxt; int ui = 0;
    if (!S.next(0, cur)) return;
    f32x4 acc[2][2][4][2];
#pragma unroll
    for (int a = 0; a < 2; ++a)
#pragma unroll
        for (int b = 0; b < 2; ++b)
#pragma unroll
            for (int m = 0; m < 4; ++m)
#pragma unroll
                for (int n = 0; n < 2; ++n) acc[a][b][m][n] = (f32x4){0.f, 0.f, 0.f, 0.f};
    bf16x8 At[4][2], B0[2][2], B1[2][2];
    const char* cA = (const char*)g.A + (size_t)cur.pm * tstep; const char* cB = (const char*)g.Bt + (size_t)cur.pn * tstep;
    S.a_ready(cur);
    PG8_STAGE(PG8_SB(0, 0), cB, voffB); PG8_STAGE(PG8_SA(0, 0), cA, voffA); PG8_STAGE(PG8_SB(0, 1), cB + hstep, voffB); PG8_STAGE(PG8_SA(0, 1), cA + hstep, voffA);
    if (wr == 1) PG8_BAR;
    PG8_WAIT_V(4); PG8_BAR;
    PG8_STAGE(PG8_SB(1, 0), cB + kstep, voffB); PG8_STAGE(PG8_SA(1, 0), cA + kstep, voffA); PG8_STAGE(PG8_SB(1, 1), cB + hstep + kstep, voffB);
    PG8_WAIT_V(6); PG8_BAR;
    PG8_STAMP();
    for (;;) {
        const bool has_next = S.next(ui + 1, nxt);
        const char* nA = has_next ? (const char*)g.A + (size_t)nxt.pm * tstep : cA; const char* nB = has_next ? (const char*)g.Bt + (size_t)nxt.pn * tstep : cB;
        for (int t = 0; t < nt; t += 2) {
            const bool last = (t == nt - 2);
            const char* a1 = cA + (size_t)(t + 1) * kstep;
            const char* a2 = last ? nA : cA + (size_t)(t + 2) * kstep; const char* b2 = last ? nB : cB + (size_t)(t + 2) * kstep;
            const char* a3 = a2 + kstep; const char* b3 = b2 + kstep;
            if (last && has_next) S.a_ready(nxt);
            PG8_LDB(B0, 0, 0); PG8_SCHED; PG8_LDA(At, 0, 0); PG8_STAGE(PG8_SA(1, 1), a1 + hstep, voffA);
            PG8_WAIT_L(8); PG8_BAR; PG8_WAIT_L(0); PG8_MMA(0, 0, At, B0); PG8_BAR; PG8_SCHED;
            PG8_LDB(B1, 0, 1); PG8_STAGE(PG8_SB(0, 0), b2, voffB);
            PG8_BAR; PG8_WAIT_L(0); PG8_MMA(0, 1, At, B1); PG8_BAR;
            PG8_LDA(At, 0, 1); PG8_STAGE(PG8_SA(0, 0), a2, voffA);
            PG8_BAR; PG8_WAIT_L(0); PG8_MMA(1, 0, At, B0); PG8_BAR; PG8_SCHED;
            PG8_STAGE(PG8_SB(0, 1), b2 + hstep, voffB);
            PG8_WAIT_V(6); PG8_BAR; PG8_MMA(1, 1, At, B1); PG8_BAR;
            PG8_LDB(B0, 1, 0); PG8_SCHED; PG8_LDA(At, 1, 0); PG8_STAGE(PG8_SA(0, 1), a2 + hstep, voffA);
            PG8_WAIT_L(8); PG8_BAR; PG8_WAIT_L(0); PG8_MMA(0, 0, At, B0); PG8_BAR; PG8_SCHED;
            PG8_LDB(B1, 1, 1); PG8_STAGE(PG8_SB(1, 0), b3, voffB);
            PG8_BAR; PG8_WAIT_L(0); PG8_MMA(0, 1, At, B1); PG8_BAR;
            PG8_LDA(At, 1, 1); PG8_STAGE(PG8_SA(1, 0), a3, voffA);
            PG8_BAR; PG8_WAIT_L(0); PG8_MMA(1, 0, At, B0); PG8_BAR; PG8_SCHED;
            PG8_STAGE(PG8_SB(1, 1), b3 + hstep, voffB);
            PG8_WAIT_V(6); PG8_BAR; PG8_MMA(1, 1, At, B1); PG8_BAR;
        }
        PG8_STAMP();
        if constexpr (!Epi::AFTER_DRAIN) { E(acc, cur, wr, wc, fr, fq); S.done(cur); }
        PG8_STAMP();
        if (!has_next) break;
#pragma unroll
        for (int a = 0; a < 2; ++a)
#pragma unroll
            for (int b = 0; b < 2; ++b)
#pragma unroll
                for (int m = 0; m < 4; ++m)
#pragma unroll
                    for (int n = 0; n < 2; ++n) acc[a][b][m][n] = (f32x4){0.f, 0.f, 0.f, 0.f};
        cur = nxt; cA = nA; cB = nB; ++ui;
    }
    PG8_WAIT_V(0);
    if (wr == 0) PG8_BAR;
    PG8_BAR;
    if constexpr (Epi::AFTER_DRAIN) { E.fused(acc, cur, wr, wc, fr, fq, lds, wid, lane); S.done(cur); }
    PG8_STAMP();
    if (STAMP && wid == 0) { stamps[lane] = lane < nts ? (((unsigned long long)(unsigned)ts_hi << 32) | (unsigned)ts_lo) : 0ull;
        if (lane == 62) stamps[62] = rt_entry; if (lane == 63) stamps[63] = (unsigned long long)wall_clock64(); }
#undef PG8_STAMP
#undef PG8_SA
#undef PG8_SB
#undef PG8_STAGE
#undef PG8_LDA
#undef PG8_LDB
#undef PG8_MMA
#undef PG8_WAIT_V
#undef PG8_WAIT_L
#undef PG8_BAR
#undef PG8_SCHED
}
}

typedef unsigned short bf16_t;
typedef float f32x4 __attribute__((ext_vector_type(4)));
__device__ __forceinline__ int opaque_tid() { int t = threadIdx.x; asm volatile("" : "+v"(t)); return t; }
typedef unsigned u32x4 __attribute__((ext_vector_type(4)));

__device__ __forceinline__ bf16_t f2bf(float f) { return __builtin_bit_cast(bf16_t, (__bf16)f); }
typedef __bf16 bf16x2n_t __attribute__((ext_vector_type(2)));
typedef float f32x2n_t __attribute__((ext_vector_type(2)));
__device__ __forceinline__ unsigned pack2bf(float lo, float hi) { return __builtin_bit_cast(unsigned, __builtin_convertvector((f32x2n_t){lo, hi}, bf16x2n_t)); }
__device__ __forceinline__ float bf2f(bf16_t b) { return __uint_as_float(((unsigned)b) << 16); }
__device__ __forceinline__ float sigmoidf_(float x) { return __builtin_amdgcn_rcpf(1.f + __expf(-x)); }
__device__ __forceinline__ float gelu_tanh(float x) {
    float u = 0.7978845608028654f * (x + 0.044715f * x * x * x);
    return 0.5f * x * (1.f + tanhf(u));
}
__device__ __forceinline__ float gelu_erf(float x) { return 0.5f * x * (1.f + erff(x * 0.70710678118654752f)); }
__device__ __forceinline__ float gelu_as(float v) {
    const float av = fabsf(v), d = av * 0.2316418882f + 1.0f;
    const float t = __builtin_amdgcn_rcpf(d);
    float q = t * 0.5307027145f + (-0.7265760135f); q = q * t + 0.7107068705f; q = q * t + (-0.142248368f); q = q * t + 0.127414796f; q = q * t;
    const float e = __builtin_amdgcn_exp2f((v * v) * (-0.72134752044f));
    const float m = v * (q * e), r = v - m;
    return v < 0.f ? m : r;
}

struct EpiResF32 {
    static constexpr bool PERM = false, AFTER_DRAIN = false;
    float* C; int ldc; const float* X; float alpha;
    __device__ __forceinline__ void operator()(const pg8::f32x4 (&acc)[2][2][4][2], const pg8::Unit& u, int wr, int wc, int fr, int fq) const {
        const int row0 = u.pm * pg8::BM + wr * 64 + fr, col0 = u.pn * pg8::BM + wc * 32 + 4 * fq;
#pragma unroll
        for (int ai = 0; ai < 2; ++ai)
#pragma unroll
            for (int m = 0; m < 4; ++m) {
                const size_t ro = (size_t)(row0 + ai * pg8::HALF + m * 16) * ldc + col0;
#pragma unroll
                for (int bj = 0; bj < 2; ++bj)
#pragma unroll
                    for (int n = 0; n < 2; ++n) {
                        const pg8::f32x4 xv = *(const pg8::f32x4*)(X + ro + bj * pg8::HALF + n * 16);
                        *(pg8::f32x4*)(C + ro + bj * pg8::HALF + n * 16) = acc[ai][bj][m][n] + xv * alpha;
                    }
            }
    }
};
struct EpiBf16 {
    static constexpr bool PERM = true, AFTER_DRAIN = false;
    bf16_t* O; int ldc;
    __device__ __forceinline__ void operator()(const pg8::f32x4 (&acc)[2][2][4][2], const pg8::Unit& u, int wr, int wc, int fr, int fq) const {
        const int row0 = u.pm * pg8::BM + wr * 64 + fr;
        const int col0 = u.pn * pg8::BM + wc * 32 + 8 * fq;
#pragma unroll
        for (int ai = 0; ai < 2; ++ai)
#pragma unroll
            for (int m = 0; m < 4; ++m) {
                bf16_t* rowp = O + (size_t)(row0 + ai * pg8::HALF + m * 16) * ldc + col0;
#pragma unroll
                for (int bj = 0; bj < 2; ++bj) {
                    const pg8::f32x4 v0 = acc[ai][bj][m][0], v1 = acc[ai][bj][m][1];
                    pg8::u32x4 w; w.x = pg8::cvt_pk_bf16(v0[0], v0[1]); w.y = pg8::cvt_pk_bf16(v0[2], v0[3]); w.z = pg8::cvt_pk_bf16(v1[0], v1[1]); w.w = pg8::cvt_pk_bf16(v1[2], v1[3]);
                    *(pg8::u32x4*)(rowp + bj * pg8::HALF) = w;
                }
            }
    }
};

__device__ __forceinline__ void cvt_unit(size_t unit, const float* __restrict__ src, bf16_t* __restrict__ dst) {
    const size_t o = unit * 4096 + (size_t)threadIdx.x * 8;
    const f32x4 a = *(const f32x4*)(src + o), b = *(const f32x4*)(src + o + 4);
    u32x4 w; w.x = pack2bf(a[0], a[1]); w.y = pack2bf(a[2], a[3]); w.z = pack2bf(b[0], b[1]); w.w = pack2bf(b[2], b[3]);
    *(u32x4*)(dst + o) = w;
}
__device__ __forceinline__ void transpose_unit(int unit, const float* __restrict__ in, bf16_t* __restrict__ out, int R, int C, float* tile  ,
                                               const float* __restrict__ rowscale = nullptr, const float* __restrict__ rowbias = nullptr, float* __restrict__ p1 = nullptr, float* __restrict__ p2 = nullptr) {
    const int ntc = C / 64;
    const int r0 = (unit / ntc) * 64, c0 = (unit % ntc) * 64;
    float* tile2 = tile + 64 * 65;
    __syncthreads();
#pragma unroll
    for (int i = 0; i < 8; i++) {
        int e = threadIdx.x + i * NTHR;
        int r = e >> 6, c = e & 63;
        const float v = in[(size_t)(r0 + r) * C + c0 + c];
        tile[r * 65 + c] = rowscale ? v * rowscale[r0 + r] : v;
        if (rowscale) tile2[r * 65 + c] = v * rowbias[r0 + r];
    }
    __syncthreads();
#pragma unroll
    for (int i = 0; i < 8; i++) {
        int e = threadIdx.x + i * NTHR;
        int c = e >> 6, r = e & 63;
        out[(size_t)(c0 + c) * R + r0 + r] = f2bf(tile[r * 65 + c]);
    }
    if (rowscale && threadIdx.x < 64) {
        float s1 = 0.f, s2 = 0.f;
        for (int r = 0; r < 64; ++r) { s1 += tile[r * 65 + threadIdx.x]; s2 += tile2[r * 65 + threadIdx.x]; }
        p1[(size_t)(r0 / 64) * C + c0 + threadIdx.x] = s1;
        p2[(size_t)(r0 / 64) * C + c0 + threadIdx.x] = s2;
    }
}

typedef __bf16 bf16x2_t __attribute__((ext_vector_type(2)));
__device__ __forceinline__ float dot2bf(unsigned a, unsigned b, float c) { return __builtin_amdgcn_fdot2_f32_bf16(__builtin_bit_cast(bf16x2_t, a), __builtin_bit_cast(bf16x2_t, b), c, false); }
template <int CTRL> __device__ __forceinline__ float dppf(float x) { return __builtin_bit_cast(float, __builtin_amdgcn_mov_dpp(__builtin_bit_cast(int, x), CTRL, 0xf, 0xf, true)); }
#define DPP_XOR1 0xB1
#define DPP_XOR2 0x4E
#define DPP_XOR7 0x141
#define DPP_XOR8 0x128
__device__ __forceinline__ float xrow16_sum(float x) {
    auto s = __builtin_amdgcn_permlane16_swap(__float_as_uint(x), __float_as_uint(x), false, false);
    x = __uint_as_float(s[0]) + __uint_as_float(s[1]);
    auto t = __builtin_amdgcn_permlane32_swap(__float_as_uint(x), __float_as_uint(x), false, false);
    return __uint_as_float(t[0]) + __uint_as_float(t[1]);
}
__device__ __forceinline__ float wave_sum(float x) {
    x += dppf<DPP_XOR1>(x); x += dppf<DPP_XOR2>(x); x += dppf<DPP_XOR7>(x); x += dppf<DPP_XOR8>(x);
    return xrow16_sum(x);
}
__device__ __forceinline__ float tr_reduce16(float (&p)[16], int c) {
#define TR_STEP(HALF, CTRL, BIT) _Pragma("unroll") for (int h = 0; h < (HALF); ++h) { \
        const float lo_ = p[h], hi_ = p[h + (HALF)]; const float t1_ = lo_ + dppf<CTRL>(lo_), t2_ = hi_ + dppf<CTRL>(hi_); \
        p[h] = (c & (BIT)) ? t2_ : t1_; }
    TR_STEP(8, DPP_XOR8, 8) TR_STEP(4, DPP_XOR7, 4) TR_STEP(2, DPP_XOR2, 2) TR_STEP(1, DPP_XOR1, 1)
#undef TR_STEP
    return xrow16_sum(p[0]);
}
#define G_LOAD(R, tab, idreg, k0) do { _Pragma("unroll") for (int j_ = 0; j_ < 8; ++j_) { \
        const int id_ = __builtin_amdgcn_readlane((idreg), (k0) + j_); \
        const u32x4* rp_ = (const u32x4*)((tab) + (size_t)id_ * 1024); \
        R[j_][0] = rp_[lane]; R[j_][1] = rp_[64 + lane]; } } while (0)
#define G_DOT(R, p, o) do { _Pragma("unroll") for (int j_ = 0; j_ < 8; ++j_) { \
        float d0_ = dot2bf(R[j_][0].x, xp[0], 0.f), d1_ = dot2bf(R[j_][0].y, xp[1], 0.f); \
        d0_ = dot2bf(R[j_][0].z, xp[2], d0_); d1_ = dot2bf(R[j_][0].w, xp[3], d1_); \
        d0_ = dot2bf(R[j_][1].x, xp[4], d0_); d1_ = dot2bf(R[j_][1].y, xp[5], d1_); \
        d0_ = dot2bf(R[j_][1].z, xp[6], d0_); d1_ = dot2bf(R[j_][1].w, xp[7], d1_); \
        p[(o) + j_] = d0_ + d1_; } } while (0)
#define G_ACC1(u_, i_, w_) do { y[(i_)] = fmaf((w_), __uint_as_float((u_) << 16), y[(i_)]); y[(i_) + 1] = fmaf((w_), __uint_as_float((u_) & 0xffff0000u), y[(i_) + 1]); } while (0)
#define G_ACC(R, wreg, k0) do { _Pragma("unroll") for (int j_ = 0; j_ < 8; ++j_) { \
        const float w_ = __uint_as_float((unsigned)__builtin_amdgcn_readlane((int)__float_as_uint(wreg), (k0) + j_)); \
        G_ACC1(R[j_][0].x, 0, w_); G_ACC1(R[j_][0].y, 2, w_); G_ACC1(R[j_][0].z, 4, w_); G_ACC1(R[j_][0].w, 6, w_); \
        G_ACC1(R[j_][1].x, 8, w_); G_ACC1(R[j_][1].y, 10, w_); G_ACC1(R[j_][1].z, 12, w_); G_ACC1(R[j_][1].w, 14, w_); } } while (0)

typedef short bf16x8_t __attribute__((ext_vector_type(8)));
typedef float f32x16 __attribute__((ext_vector_type(16)));
#define HG_P272 272
#define HG_P144 144
#define HG_QH   0
#define HG_KH   (HG_QH + 64 * 272)
#define HG_QT   (HG_KH + 64 * 272)
#define HG_VT   (HG_QT + 64 * 272)
#define HG_ST   (HG_VT + 128 * 144)
#define HG_PM   (HG_ST + 128 * 272)
#define HG_SEG  (HG_PM + 64 * 144)
#define HG_RSQ  (HG_SEG + 4096)
#define HG_END  (HG_RSQ + 1024)

__device__ __forceinline__ float hg_lb(const float* __restrict__ lbl, int c) { return 1.f / (1.f + __expf(lbl[512 + c] - lbl[c])); }
__device__ __forceinline__ float sel4(const float (&v)[4], int k) { return k == 0 ? v[0] : k == 1 ? v[1] : k == 2 ? v[2] : v[3]; }
__device__ __forceinline__ float pklo(unsigned w) { return __uint_as_float(w << 16); }
__device__ __forceinline__ float pkhi(unsigned w) { return __uint_as_float(w & 0xffff0000u); }
__device__ __forceinline__ void hg_prep(const unsigned (&fw)[8], float lb0, float lb1, int dp, int ts, float* seg  ,
                                        float (&kk)[16], float (&bb)[16], float (&tot)[2], float (&bref)[2]) {
    float run0 = 0.f, run1 = 0.f;
#pragma unroll
    for (int i = 0; i < 8; ++i) {
        const float s0 = sigmoidf_(pklo(fw[i])), s1 = sigmoidf_(pkhi(fw[i]));
        kk[2 * i] = (1.f - lb0) * (1.f - s0); kk[2 * i + 1] = (1.f - lb1) * (1.f - s1);
        run0 += 0.6931471805599453f * __builtin_amdgcn_logf(lb0 + (1.f - lb0) * s0); run1 += 0.6931471805599453f * __builtin_amdgcn_logf(lb1 + (1.f - lb1) * s1);
        bb[2 * i] = run0; bb[2 * i + 1] = run1;
    }
    *(float2*)(seg + ts * 128 + 2 * dp) = make_float2(run0, run1);
    __syncthreads();
    float pre0 = 0.f, pre1 = 0.f, t0 = 0.f, t1 = 0.f, r0 = 0.f, r1 = 0.f;
#pragma unroll
    for (int s = 0; s < 8; ++s) {
        const float2 v = *(const float2*)(seg + s * 128 + 2 * dp);
        if (s < ts) { pre0 += v.x; pre1 += v.y; }
        if (s < 4) { r0 += v.x; r1 += v.y; }
        t0 += v.x; t1 += v.y;
    }
    tot[0] = t0; tot[1] = t1; bref[0] = r0; bref[1] = r1;
#pragma unroll
    for (int i = 0; i < 8; ++i) { bb[2 * i] += pre0; bb[2 * i + 1] += pre1; }
}
__device__ __forceinline__ void hg_store8x2(unsigned char* base, int dp, int ts, const float (&v)[16]) {
    u32x4 w0, w1;
    w0.x = pack2bf(v[0], v[2]); w0.y = pack2bf(v[4], v[6]); w0.z = pack2bf(v[8], v[10]); w0.w = pack2bf(v[12], v[14]);
    w1.x = pack2bf(v[1], v[3]); w1.y = pack2bf(v[5], v[7]); w1.z = pack2bf(v[9], v[11]); w1.w = pack2bf(v[13], v[15]);
    *(u32x4*)(base + (2 * dp) * HG_P144 + ts * 16) = w0;
    *(u32x4*)(base + (2 * dp + 1) * HG_P144 + ts * 16) = w1;
}
__device__ __forceinline__ void hg_store8x2_raw(unsigned char* base, int dp, int ts, const unsigned (&p)[8]) {
    u32x4 w0, w1;
    w0.x = __builtin_amdgcn_perm(p[1], p[0], 0x05040100u); w0.y = __builtin_amdgcn_perm(p[3], p[2], 0x05040100u);
    w0.z = __builtin_amdgcn_perm(p[5], p[4], 0x05040100u); w0.w = __builtin_amdgcn_perm(p[7], p[6], 0x05040100u);
    w1.x = __builtin_amdgcn_perm(p[1], p[0], 0x07060302u); w1.y = __builtin_amdgcn_perm(p[3], p[2], 0x07060302u);
    w1.z = __builtin_amdgcn_perm(p[5], p[4], 0x07060302u); w1.w = __builtin_amdgcn_perm(p[7], p[6], 0x07060302u);
    *(u32x4*)(base + (2 * dp) * HG_P144 + ts * 16) = w0;
    *(u32x4*)(base + (2 * dp + 1) * HG_P144 + ts * 16) = w1;
}
__device__ __forceinline__ void hg_store16(unsigned char* base, int col, int tq, const float (&v)[16]) {
    u32x4 w0, w1;
    w0.x = pack2bf(v[0], v[1]); w0.y = pack2bf(v[2], v[3]); w0.z = pack2bf(v[4], v[5]); w0.w = pack2bf(v[6], v[7]);
    w1.x = pack2bf(v[8], v[9]); w1.y = pack2bf(v[10], v[11]); w1.z = pack2bf(v[12], v[13]); w1.w = pack2bf(v[14], v[15]);
    *(u32x4*)(base + col * HG_P144 + tq * 32) = w0;
    *(u32x4*)(base + col * HG_P144 + tq * 32 + 16) = w1;
}
__device__ __forceinline__ bf16x8_t hg_frag(const unsigned char* base, int pitch, int row, int kelem) {
    return *(const bf16x8_t*)(base + row * pitch + kelem * 2);
}

struct HgP2Regs { unsigned f[8], v[8]; };
__device__ __forceinline__ void hgrn_p2_load(int unit, const bf16_t* __restrict__ h, HgP2Regs& R) {
    const int b = unit >> 9, hh = (unit >> 7) & 3, ch = unit & 127;
    const int tx = opaque_tid();
    const int dp = tx & 63, ts = tx >> 6;
    const size_t t0 = (size_t)b * SEQ + ch * 64 + ts * 8;
#pragma unroll
    for (int i = 0; i < 8; ++i) {
        const unsigned* hr = (const unsigned*)(h + (t0 + i) * INW + hh * 128) + dp;
        R.f[i] = hr[1536 / 2]; R.v[i] = hr[2048 / 2];
    }
}
__device__ __forceinline__ void hgrn_p2_body(int unit, const HgP2Regs& R, const float (&lb4)[2][4], bf16_t* __restrict__ kv, float* __restrict__ gam, unsigned char* lds) {
    const int hh = (unit >> 7) & 3;
    const int tx = opaque_tid();
    const int dp = tx & 63, ts = tx >> 6;
    const int lane = tx & 63, w = tx >> 6;
    __syncthreads();
    float kk[16], bb[16], tot[2], bref[2];
    hg_prep(R.f, sel4(lb4[0], hh), sel4(lb4[1], hh), dp, ts, (float*)(lds + HG_SEG), kk, bb, tot, bref);
    float tmp[16];
#pragma unroll
    for (int i = 0; i < 16; ++i) tmp[i] = kk[i] * __expf(tot[i & 1] - bb[i]);
    hg_store8x2(lds + HG_ST, dp, ts, tmp);
    hg_store8x2_raw(lds + HG_VT, dp, ts, R.v);
    if (ts == 0) *(float2*)(gam + (size_t)unit * 128 + 2 * dp) = make_float2(__expf(tot[0]), __expf(tot[1]));
    __syncthreads();
    const int mt = w >> 1;
    f32x16 acc[2];
#pragma unroll
    for (int n = 0; n < 2; ++n)
#pragma unroll
        for (int r = 0; r < 16; ++r) acc[n][r] = 0.f;
#pragma unroll
    for (int ks = 0; ks < 4; ++ks) {
        const int kel = ks * 16 + 8 * (lane >> 5);
        const bf16x8_t a = hg_frag(lds + HG_VT, HG_P144, mt * 32 + (lane & 31), kel);
#pragma unroll
        for (int n = 0; n < 2; ++n) {
            const int nt = 2 * (w & 1) + n;
            const bf16x8_t bf = hg_frag(lds + HG_ST, HG_P144, nt * 32 + (lane & 31), kel);
            acc[n] = __builtin_amdgcn_mfma_f32_32x32x16_bf16(a, bf, acc[n], 0, 0, 0);
        }
    }
    bf16_t* o = kv + (size_t)unit * 16384;
#pragma unroll
    for (int n = 0; n < 2; ++n) {
        const int nt = 2 * (w & 1) + n;
#pragma unroll
        for (int r = 0; r < 16; ++r) {
            const int e = mt * 32 + (r & 3) + 8 * (r >> 2) + 4 * (lane >> 5);
            o[e * 128 + nt * 32 + (lane & 31)] = f2bf(acc[n][r]);
        }
    }
}

__device__ void hgrn_scan4(int tid256, bf16_t* __restrict__ kv, const float* __restrict__ gam) {
    const int gid = blockIdx.x * 256 + tid256;
    const int bh = gid >> 12, rem = gid & 4095;
    const int d = (rem & 31) * 4;
    uint2* p = (uint2*)(kv + (size_t)bh * 128 * 16384) + rem;
    const float* gp = gam + (size_t)bh * 128 * 128 + d;
    float s0 = 0.f, s1 = 0.f, s2 = 0.f, s3 = 0.f;
    for (int c0 = 0; c0 < 128; c0 += 8) {
        uint2 kvv[8]; f32x4 g[8];
#pragma unroll
        for (int j = 0; j < 8; ++j) { kvv[j] = p[(size_t)(c0 + j) * 4096]; g[j] = *(const f32x4*)(gp + (c0 + j) * 128); }
#pragma unroll
        for (int j = 0; j < 8; ++j) {
            uint2 o; o.x = pack2bf(s0, s1); o.y = pack2bf(s2, s3);
            p[(size_t)(c0 + j) * 4096] = o;
            s0 = fmaf(g[j][0], s0, __uint_as_float(kvv[j].x << 16));
            s1 = fmaf(g[j][1], s1, __uint_as_float(kvv[j].x & 0xffff0000u));
            s2 = fmaf(g[j][2], s2, __uint_as_float(kvv[j].y << 16));
            s3 = fmaf(g[j][3], s3, __uint_as_float(kvv[j].y & 0xffff0000u));
        }
    }
}

struct HgP4Regs { u32x4 stv[4]; unsigned f[8], q[8], v[8]; bf16_t gvr[16]; };
__device__ __forceinline__ void hgrn_p4_load(int unit, const bf16_t* __restrict__ h, const bf16_t* __restrict__ st, HgP4Regs& R) {
    const int b = unit >> 9, hh = (unit >> 7) & 3, ch = unit & 127;
    const int tx = opaque_tid();
    const int dp = tx & 63, ts = tx >> 6;
    const int lane = tx & 63, w = tx >> 6;
    const size_t tb = (size_t)b * SEQ + ch * 64;
    const size_t t0 = tb + ts * 8;
    const int mt = w >> 2, nt = w & 3;
    const u32x4* sp = (const u32x4*)(st + (size_t)unit * 16384);
#pragma unroll
    for (int i = 0; i < 4; ++i) R.stv[i] = sp[tx + i * NTHR];
#pragma unroll
    for (int i = 0; i < 8; ++i) {
        const unsigned* hr = (const unsigned*)(h + (t0 + i) * INW + hh * 128) + dp;
        R.f[i] = hr[1536 / 2]; R.q[i] = hr[1024 / 2]; R.v[i] = hr[2048 / 2];
    }
#pragma unroll
    for (int r = 0; r < 16; ++r) R.gvr[r] = h[(tb + mt * 32 + (r & 3) + 8 * (r >> 2) + 4 * (lane >> 5)) * INW + 2560 + hh * 128 + nt * 32 + (lane & 31)];
}
__device__ __forceinline__ void hgrn_p4_body(int unit, const HgP4Regs& R, const float (&lb4)[2][4], const float (&gn4)[4], bf16_t* __restrict__ mixin, unsigned char* lds) {
    const int b = unit >> 9, hh = (unit >> 7) & 3, ch = unit & 127;
    const int tx = opaque_tid();
    const int dp = tx & 63, ts = tx >> 6;
    const int lane = tx & 63, w = tx >> 6;
    const size_t tb = (size_t)b * SEQ + ch * 64;
    const int mt = w >> 2, nt = w & 3;
    __syncthreads();
    float kk[16], bb[16], tot[2], bref[2];
    hg_prep(R.f, sel4(lb4[0], hh), sel4(lb4[1], hh), dp, ts, (float*)(lds + HG_SEG), kk, bb, tot, bref);
    const float eref0 = __expf(bref[0]), eref1 = __expf(bref[1]);
#pragma unroll
    for (int i = 0; i < 8; ++i) {
        const float q0 = pklo(R.q[i]), q1 = pkhi(R.q[i]);
        const int t = ts * 8 + i;
        const float qh0 = q0 * __expf(bb[2 * i] - bref[0]), qh1 = q1 * __expf(bb[2 * i + 1] - bref[1]);
        *(unsigned*)(lds + HG_QH + t * HG_P272 + dp * 4) = pack2bf(qh0, qh1);
        *(unsigned*)(lds + HG_KH + t * HG_P272 + dp * 4) = pack2bf(kk[2 * i] * __expf(bref[0] - bb[2 * i]), kk[2 * i + 1] * __expf(bref[1] - bb[2 * i + 1]));
        *(unsigned*)(lds + HG_QT + t * HG_P272 + dp * 4) = pack2bf(qh0 * eref0, qh1 * eref1);
    }
    hg_store8x2_raw(lds + HG_VT, dp, ts, R.v);
    {
#pragma unroll
        for (int i = 0; i < 4; ++i) {
            const int pc = tx + i * NTHR;
            *(u32x4*)(lds + HG_ST + (pc >> 4) * HG_P272 + (pc & 15) * 16) = R.stv[i];
        }
    }
    __syncthreads();
    f32x16 acc;
#pragma unroll
    for (int r = 0; r < 16; ++r) acc[r] = 0.f;
#pragma unroll
    for (int ks = 0; ks < 8; ++ks) {
        const int kel = ks * 16 + 8 * (lane >> 5);
        const bf16x8_t a = hg_frag(lds + HG_QT, HG_P272, mt * 32 + (lane & 31), kel);
        const bf16x8_t bf = hg_frag(lds + HG_ST, HG_P272, nt * 32 + (lane & 31), kel);
        acc = __builtin_amdgcn_mfma_f32_32x32x16_bf16(a, bf, acc, 0, 0, 0);
    }
    if (w < 4) {
        const int pm = w >> 1, pn = w & 1;
        f32x16 pa;
#pragma unroll
        for (int r = 0; r < 16; ++r) pa[r] = 0.f;
#pragma unroll
        for (int ks = 0; ks < 8; ++ks) {
            const int kel = ks * 16 + 8 * (lane >> 5);
            const bf16x8_t a = hg_frag(lds + HG_QH, HG_P272, pm * 32 + (lane & 31), kel);
            const bf16x8_t bf = hg_frag(lds + HG_KH, HG_P272, pn * 32 + (lane & 31), kel);
            pa = __builtin_amdgcn_mfma_f32_32x32x16_bf16(a, bf, pa, 0, 0, 0);
        }
        const int s = pn * 32 + (lane & 31);
#pragma unroll
        for (int r = 0; r < 16; ++r) {
            const int t = pm * 32 + (r & 3) + 8 * (r >> 2) + 4 * (lane >> 5);
            const float pv = (s <= t) ? pa[r] : 0.f;
            *(bf16_t*)(lds + HG_PM + t * HG_P144 + s * 2) = f2bf(pv);
        }
    }
    __syncthreads();
#pragma unroll
    for (int ks = 0; ks < 4; ++ks) {
        const int kel = ks * 16 + 8 * (lane >> 5);
        const bf16x8_t a = hg_frag(lds + HG_PM, HG_P144, mt * 32 + (lane & 31), kel);
        const bf16x8_t bf = hg_frag(lds + HG_VT, HG_P144, nt * 32 + (lane & 31), kel);
        acc = __builtin_amdgcn_mfma_f32_32x32x16_bf16(a, bf, acc, 0, 0, 0);
    }
    float* rsq = (float*)(lds + HG_RSQ);
#pragma unroll
    for (int r = 0; r < 16; ++r) {
        float v = acc[r] * acc[r];
        v += dppf<DPP_XOR1>(v); v += dppf<DPP_XOR2>(v); v += dppf<DPP_XOR7>(v); v += dppf<DPP_XOR8>(v);
        auto sw = __builtin_amdgcn_permlane16_swap(__float_as_uint(v), __float_as_uint(v), false, false);
        v = __uint_as_float(sw[0]) + __uint_as_float(sw[1]);
        if ((lane & 31) == 0) rsq[(mt * 32 + (r & 3) + 8 * (r >> 2) + 4 * (lane >> 5)) * 4 + nt] = v;
    }
    __syncthreads();
    const int e = nt * 32 + (lane & 31);
    const float gn = sel4(gn4, hh);
#pragma unroll
    for (int r = 0; r < 16; ++r) {
        const int t = mt * 32 + (r & 3) + 8 * (r >> 2) + 4 * (lane >> 5);
        const f32x4 q4 = *(const f32x4*)(rsq + t * 4);
        const float rs = __builtin_amdgcn_rsqf((q4[0] + q4[1] + q4[2] + q4[3]) * (1.f / 128.f) + 1e-5f);
        const float gv = bf2f(R.gvr[r]);
        const float y = acc[r] * rs * gn * (gv * sigmoidf_(gv));
        mixin[(tb + t) * DM + 512 + hh * 128 + e] = f2bf(y);
    }
}


#define HD __device__ __forceinline__
#ifndef HD
#define HD __host__ __device__ __forceinline__
#endif
HD void sort16_desc(float (&v)[16]) {
#pragma unroll
    for (int k = 2; k <= 16; k <<= 1) {
#pragma unroll
        for (int j = k >> 1; j > 0; j >>= 1) {
#pragma unroll
            for (int i = 0; i < 16; ++i) {
                const int l = i ^ j;
                if (l > i) {
                    const bool desc = ((i & k) == 0);
                    const float a = v[i], b = v[l];
                    const float hi = fmaxf(a, b), lo = fminf(a, b);
                    v[i] = desc ? hi : lo; v[l] = desc ? lo : hi;
                }
            }
        }
    }
}
HD void merge_top16(float (&L)[16], const float (&B)[16]) {
#pragma unroll
    for (int i = 0; i < 16; ++i) L[i] = fmaxf(L[i], B[15 - i]);
#pragma unroll
    for (int j = 8; j > 0; j >>= 1) {
#pragma unroll
        for (int i = 0; i < 16; ++i) {
            const int l = i ^ j;
            if (l > i) { const float a = L[i], b = L[l]; L[i] = fmaxf(a, b); L[l] = fminf(a, b); }
        }
    }
}
HD void insert16(float (&L)[16], float x) {
#pragma unroll
    for (int i = 0; i < 16; ++i) { const float hi = fmaxf(L[i], x); x = fminf(L[i], x); L[i] = hi; }
}

#define TK_SK    0
#define TK_LIST  (2 * 128 * 272)
#define TK_END   (TK_LIST + 2 * 128 * 64)
__device__ void topk_phase(const bf16_t* __restrict__ q, const bf16_t* __restrict__ skb, int* __restrict__ idx, float* __restrict__ gate, unsigned char* lds) {
    const int tx = opaque_tid();
    const int lane = tx & 63, w = tx >> 6;
    const int h = blockIdx.x & 7;
    __syncthreads();
    {
        const u32x4* sp = (const u32x4*)(skb + (size_t)h * 2 * 16384);
#pragma unroll
        for (int i = 0; i < 8; ++i) {
            const int pc = tx + i * NTHR;
            *(u32x4*)(lds + TK_SK + (pc >> 11) * (128 * 272) + ((pc >> 4) & 127) * 272 + (pc & 15) * 16) = sp[pc];
        }
    }
    __syncthreads();
    const int p = w & 1, tile = w >> 1;
    for (int tb = blockIdx.x >> 3; tb < T_TOK / 128; tb += (gridDim.x >> 3)) {
        {
            const int t = tb * 128 + tile * 32 + (lane & 31);
            bf16x8_t bq[8];
            const bf16_t* qp = q + (size_t)t * 2048 + h * 256 + p * 128 + 8 * (lane >> 5);
#pragma unroll
            for (int ks = 0; ks < 8; ++ks) bq[ks] = *(const bf16x8_t*)(qp + ks * 16);
            float L[16];
            const unsigned char* skp = lds + TK_SK + p * (128 * 272);
#pragma unroll
            for (int mt = 0; mt < 4; ++mt) {
                f32x16 acc;
#pragma unroll
                for (int r = 0; r < 16; ++r) acc[r] = 0.f;
#pragma unroll
                for (int ks = 0; ks < 8; ++ks) {
                    const bf16x8_t a = hg_frag(skp, 272, mt * 32 + (lane & 31), ks * 16 + 8 * (lane >> 5));
                    acc = __builtin_amdgcn_mfma_f32_32x32x16_bf16(a, bq[ks], acc, 0, 0, 0);
                }
                float v[16];
#pragma unroll
                for (int r = 0; r < 16; ++r) {
                    const unsigned n = (unsigned)(mt * 32 + (r & 3) + 8 * (r >> 2)) + 4u * (unsigned)(lane >> 5);
                    v[r] = __uint_as_float((__float_as_uint(acc[r]) & ~127u) | n);
                }
                sort16_desc(v);
                if (mt == 0) {
#pragma unroll
                    for (int r = 0; r < 16; ++r) L[r] = v[r];
                } else merge_top16(L, v);
            }
            float Bx[16];
#pragma unroll
            for (int k = 0; k < 16; ++k) Bx[k] = __shfl_xor(L[k], 32);
            merge_top16(L, Bx);
            if (lane < 32) {
                f32x4* lp = (f32x4*)(lds + TK_LIST + (p * 128 + tile * 32 + lane) * 64);
                lp[0] = (f32x4){L[0], L[1], L[2], L[3]}; lp[1] = (f32x4){L[4], L[5], L[6], L[7]};
                lp[2] = (f32x4){L[8], L[9], L[10], L[11]}; lp[3] = (f32x4){L[12], L[13], L[14], L[15]};
            }
        }
        __syncthreads();
        if (tx < 128) {
            const float* l0 = (const float*)(lds + TK_LIST) + tx * 16;
            const float* l1 = (const float*)(lds + TK_LIST) + (128 + tx) * 16;
            float s0[16], s1[16];
#pragma unroll
            for (int k = 0; k < 4; ++k) {
                const f32x4 a = *(const f32x4*)(l0 + 4 * k), b2 = *(const f32x4*)(l1 + 4 * k);
                s0[4 * k] = a[0]; s0[4 * k + 1] = a[1]; s0[4 * k + 2] = a[2]; s0[4 * k + 3] = a[3];
                s1[4 * k] = b2[0]; s1[4 * k + 1] = b2[1]; s1[4 * k + 2] = b2[2]; s1[4 * k + 3] = b2[3];
            }
            float C0[16], C1[16], C2[16], c48 = 0.f, c49 = 0.f;
            int cnt = 0;
#pragma unroll
            for (int i = 0; i < 16; ++i) {
#pragma unroll
                for (int j = 0; j < 16; ++j) {
                    if ((i + 1) * (j + 1) <= 16) {
                        const float cv = __uint_as_float((__float_as_uint(s0[i] + s1[j]) & ~255u) | (unsigned)(i * 16 + j));
                        if (cnt < 16) C0[cnt & 15] = cv; else if (cnt < 32) C1[cnt & 15] = cv; else if (cnt < 48) C2[cnt & 15] = cv; else if (cnt == 48) c48 = cv; else c49 = cv;
                        ++cnt;
                    }
                }
            }
            sort16_desc(C0); sort16_desc(C1); sort16_desc(C2);
            merge_top16(C0, C1); merge_top16(C0, C2);
            insert16(C0, c48); insert16(C0, c49);
            const float mx = __uint_as_float(__float_as_uint(C0[0]) & ~255u);
            float e[16]; float sum = 0.f;
#pragma unroll
            for (int k = 0; k < 16; ++k) { e[k] = __expf(__uint_as_float(__float_as_uint(C0[k]) & ~255u) - mx); sum += e[k]; }
            const float inv = 1.f / sum;
            int id[16];
#pragma unroll
            for (int k = 0; k < 16; ++k) {
                const unsigned pos = __float_as_uint(C0[k]) & 255u;
                const unsigned k0 = __float_as_uint(l0[pos >> 4]) & 127u, k1 = __float_as_uint(l1[pos & 15]) & 127u;
                id[k] = (int)(k0 * 128u + k1);
                e[k] *= inv;
            }
            const size_t o = ((size_t)(tb * 128 + tx) * 8 + h) * 16;
#pragma unroll
            for (int k = 0; k < 4; ++k) {
                *(u32x4*)(idx + o + 4 * k) = (u32x4){(unsigned)id[4 * k], (unsigned)id[4 * k + 1], (unsigned)id[4 * k + 2], (unsigned)id[4 * k + 3]};
                *(f32x4*)(gate + o + 4 * k) = (f32x4){e[4 * k], e[4 * k + 1], e[4 * k + 2], e[4 * k + 3]};
            }
        }
        __syncthreads();
    }
}


typedef float f32x2_t __attribute__((ext_vector_type(2)));
__device__ __forceinline__ unsigned pack_i8x4(float a, float b, float c, float d) {
    const int ia = (int)__builtin_rintf(a), ib = (int)__builtin_rintf(b), ic = (int)__builtin_rintf(c), id = (int)__builtin_rintf(d);
    return ((unsigned)ia & 0xffu) | (((unsigned)ib & 0xffu) << 8) | (((unsigned)ic & 0xffu) << 16) | ((unsigned)id << 24);
}

__device__ __forceinline__ void quant_row(const float* __restrict__ src, unsigned char* __restrict__ dst, float* __restrict__ inv, int row, int lane,
                                          const float* __restrict__ gcol = nullptr, const float* __restrict__ bcol = nullptr, float* __restrict__ cu1 = nullptr, float* __restrict__ cu2 = nullptr, bool as_int8 = false) {
    const float* rp = src + (size_t)row * 1024 + 16 * lane;
    f32x4 a[4];
#pragma unroll
    for (int i = 0; i < 4; ++i) a[i] = *(const f32x4*)(rp + 4 * i);
    if (gcol) {
        float t1 = 0.f, t2 = 0.f;
#pragma unroll
        for (int i = 0; i < 4; ++i) {
            const f32x4 gv = *(const f32x4*)(gcol + 16 * lane + 4 * i), bv = *(const f32x4*)(bcol + 16 * lane + 4 * i);
#pragma unroll
            for (int k = 0; k < 4; ++k) { t2 += a[i][k] * bv[k]; a[i][k] *= gv[k]; t1 += a[i][k]; }
        }
        t1 = wave_sum(t1); t2 = wave_sum(t2);
        if (lane == 0) { cu1[row] = t1; cu2[row] = t2; }
    }
    float m = 0.f;
#pragma unroll
    for (int i = 0; i < 4; ++i) m = fmaxf(fmaxf(fmaxf(fabsf(a[i][0]), fabsf(a[i][1])), fmaxf(fabsf(a[i][2]), fabsf(a[i][3]))), m);
#pragma unroll
    for (int o = 32; o > 0; o >>= 1) m = fmaxf(m, __shfl_xor(m, o));
    const float qmax = as_int8 ? 127.f : 440.f;
    const float sc = m > 0.f ? qmax / m : 1.f;
    u32x4 w;
#pragma unroll
    for (int i = 0; i < 4; ++i) {
        if (as_int8) w[i] = pack_i8x4(a[i][0] * sc, a[i][1] * sc, a[i][2] * sc, a[i][3] * sc);
        else {
            int v = 0;
            v = __builtin_amdgcn_cvt_pk_fp8_f32(a[i][0] * sc, a[i][1] * sc, v, false);
            v = __builtin_amdgcn_cvt_pk_fp8_f32(a[i][2] * sc, a[i][3] * sc, v, true);
            w[i] = (unsigned)v;
        }
    }
#if PEER_SLICED
    *(u32x4*)(dst + (size_t)(lane >> 3) * (16384 * 128) + (size_t)row * 128 + (lane & 7) * 16) = w;
#else
    *(u32x4*)(dst + (size_t)row * 1024 + 16 * lane) = w;
#endif
    if (lane == 0) inv[row] = m > 0.f ? m / qmax : 1.f;
}
#define G8_LOAD(R, tab, idreg, k0) do { _Pragma("unroll") for (int j_ = 0; j_ < 16; ++j_) { \
        const int id_ = __builtin_amdgcn_readlane((idreg), (k0) + j_); \
        R[j_] = ((const u32x4*)((tab) + (size_t)id_ * 1024))[lane]; } } while (0)
#define G8_CVT(u_, f_) do { const f32x2_t lo_ = __builtin_amdgcn_cvt_pk_f32_fp8((int)(u_), false), hi_ = __builtin_amdgcn_cvt_pk_f32_fp8((int)(u_), true); \
        f_[0] = lo_.x; f_[1] = lo_.y; f_[2] = hi_.x; f_[3] = hi_.y; } while (0)
#define G8_DOT(R, p) do { _Pragma("unroll") for (int j_ = 0; j_ < 16; ++j_) { float f_[4]; float d0_, d1_; \
        G8_CVT(R[j_].x, f_); d0_ = f_[0] * xv[0]; d1_ = f_[1] * xv[1]; d0_ = fmaf(f_[2], xv[2], d0_); d1_ = fmaf(f_[3], xv[3], d1_); \
        G8_CVT(R[j_].y, f_); d0_ = fmaf(f_[0], xv[4], d0_); d1_ = fmaf(f_[1], xv[5], d1_); d0_ = fmaf(f_[2], xv[6], d0_); d1_ = fmaf(f_[3], xv[7], d1_); \
        G8_CVT(R[j_].z, f_); d0_ = fmaf(f_[0], xv[8], d0_); d1_ = fmaf(f_[1], xv[9], d1_); d0_ = fmaf(f_[2], xv[10], d0_); d1_ = fmaf(f_[3], xv[11], d1_); \
        G8_CVT(R[j_].w, f_); d0_ = fmaf(f_[0], xv[12], d0_); d1_ = fmaf(f_[1], xv[13], d1_); d0_ = fmaf(f_[2], xv[14], d0_); d1_ = fmaf(f_[3], xv[15], d1_); \
        p[j_] = d0_ + d1_; } } while (0)
#define G8_ACC(R, wreg, k0) do { _Pragma("unroll") for (int j_ = 0; j_ < 16; ++j_) { float f_[4]; \
        const float w_ = __uint_as_float((unsigned)__builtin_amdgcn_readlane((int)__float_as_uint(wreg), (k0) + j_)); \
        G8_CVT(R[j_].x, f_); y[0] = fmaf(w_, f_[0], y[0]); y[1] = fmaf(w_, f_[1], y[1]); y[2] = fmaf(w_, f_[2], y[2]); y[3] = fmaf(w_, f_[3], y[3]); \
        G8_CVT(R[j_].y, f_); y[4] = fmaf(w_, f_[0], y[4]); y[5] = fmaf(w_, f_[1], y[5]); y[6] = fmaf(w_, f_[2], y[6]); y[7] = fmaf(w_, f_[3], y[7]); \
        G8_CVT(R[j_].z, f_); y[8] = fmaf(w_, f_[0], y[8]); y[9] = fmaf(w_, f_[1], y[9]); y[10] = fmaf(w_, f_[2], y[10]); y[11] = fmaf(w_, f_[3], y[11]); \
        G8_CVT(R[j_].w, f_); y[12] = fmaf(w_, f_[0], y[12]); y[13] = fmaf(w_, f_[1], y[13]); y[14] = fmaf(w_, f_[2], y[14]); y[15] = fmaf(w_, f_[3], y[15]); } } while (0)

#define LR_XC    0
#define LR_PV    (32 * 1040)
#define LR_PS    (LR_PV + 32 * 512 * 4)
#define LR_END   (LR_PS + 1024)
#ifndef PF_LRU_F
#define PF_LRU_F 1
#endif
#ifndef PF_LRU_T
#define PF_LRU_T 1
#endif
#ifndef PF_HG2
#define PF_HG2 1
#endif
#ifndef PF_HG4
#define PF_HG4 1
#endif
struct LruConst { float cw0, cw1, cw2, cw3, cbv, bav, bxv, sp8, gv; };
__device__ __forceinline__ void lru2_const(LruConst& K, const float* __restrict__ cw, const float* __restrict__ cb, const float* __restrict__ ba, const float* __restrict__ bx,
                                           const float* __restrict__ lam, const float* __restrict__ ng) {
    const int c = opaque_tid();
    K.cw0 = cw[c]; K.cw1 = cw[512 + c]; K.cw2 = cw[1024 + c]; K.cw3 = cw[1536 + c]; K.cbv = cb[c];
    K.bav = ba[c]; K.bxv = bx[c]; K.sp8 = -8.f * log1pf(expf(-lam[c])); K.gv = ng[c];
}
template <bool FINAL> struct LruRegs { bf16_t xr[35]; bf16_t gr[FINAL ? 32 : 1]; float H; };
template <bool FINAL>
__device__ __forceinline__ void lru2_load(int unit, const bf16_t* __restrict__ h, const float* __restrict__ hseg, LruRegs<FINAL>& R) {
    const int b = unit >> 8, sg = unit & 255;
    const int c = opaque_tid();
    const size_t t0 = (size_t)b * SEQ + sg * 32;
#pragma unroll
    for (int k = 0; k < 35; ++k) R.xr[k] = (sg > 0 || k >= 3) ? h[(t0 + k - 3) * INW + c] : (bf16_t)0;
    if (FINAL) {
#pragma unroll
        for (int t = 0; t < 32; ++t) R.gr[t] = h[(t0 + t) * INW + 512 + c];
        R.H = hseg[(size_t)unit * 512 + c];
    } else {
        R.H = 0.f;
    }
}
__device__ __forceinline__ void lru2_front(const bf16_t (&xr)[35], const LruConst& K, const bf16_t* __restrict__ wT  , unsigned char* lds) {
    const int c = opaque_tid(), hh = c >> 6, lane = c & 63;
    __syncthreads();
#pragma unroll
    for (int t = 0; t < 32; ++t) {
        const float xc = K.cbv + K.cw0 * bf2f(xr[t]) + K.cw1 * bf2f(xr[t + 1]) + K.cw2 * bf2f(xr[t + 2]) + K.cw3 * bf2f(xr[t + 3]);
        *(bf16_t*)(lds + LR_XC + t * 1040 + c * 2) = f2bf(xc);
    }
    {
        f32x16 acc[2][2];
#pragma unroll
        for (int g = 0; g < 2; ++g)
#pragma unroll
            for (int nt = 0; nt < 2; ++nt)
#pragma unroll
                for (int r = 0; r < 16; ++r) acc[g][nt][r] = 0.f;
#pragma unroll
        for (int ks = 0; ks < 4; ++ks) {
            const bf16x8_t a = *(const bf16x8_t*)(lds + LR_XC + (lane & 31) * 1040 + (hh * 64 + ks * 16 + 8 * (lane >> 5)) * 2);
#pragma unroll
            for (int g = 0; g < 2; ++g)
#pragma unroll
                for (int nt = 0; nt < 2; ++nt) {
                    const bf16x8_t bw = *(const bf16x8_t*)(wT + ((size_t)(g * 8 + hh) * 64 + nt * 32 + (lane & 31)) * 64 + ks * 16 + 8 * (lane >> 5));
                    acc[g][nt] = __builtin_amdgcn_mfma_f32_32x32x16_bf16(a, bw, acc[g][nt], 0, 0, 0);
                }
        }
#pragma unroll
        for (int nt = 0; nt < 2; ++nt)
#pragma unroll
            for (int r = 0; r < 16; ++r) {
                const int t = (r & 3) + 8 * (r >> 2) + 4 * (lane >> 5);
                *(unsigned*)(lds + LR_PV + (t * 512 + hh * 64 + nt * 32 + (lane & 31)) * 4) = pack2bf(acc[0][nt][r], acc[1][nt][r]);
            }
    }
}
template <bool FINAL>
__device__ __forceinline__ void lru2_back(int unit, const LruRegs<FINAL>& R, const LruConst& K, float* __restrict__ aseg, float* __restrict__ hseg, bf16_t* __restrict__ mixin, unsigned char* lds) {
    const int b = unit >> 8, sg = unit & 255;
    const int c = opaque_tid(), hh = c >> 6, lane = c & 63;
    const size_t t0 = (size_t)b * SEQ + sg * 32;
    float H = R.H;
    float A = 1.f;
    float* ps = (float*)(lds + LR_PS);
#pragma unroll
    for (int tb = 0; tb < 32; tb += 16) {
        float sq[16];
#pragma unroll
        for (int k = 0; k < 16; ++k) {
            const int t = tb + k;
            const unsigned pre = *(const unsigned*)(lds + LR_PV + (t * 512 + c) * 4);
            const float xc = bf2f(*(const bf16_t*)(lds + LR_XC + t * 1040 + c * 2));
            const float r = sigmoidf_(__uint_as_float(pre << 16) + K.bav), ig = sigmoidf_(__uint_as_float(pre & 0xffff0000u) + K.bxv);
            const float a = __expf(K.sp8 * r);
            const float u = __builtin_amdgcn_sqrtf(fmaxf(1.f - a * a, 0.f)) * (ig * xc);
            H = fmaf(a, H, u);
            if (FINAL) {
                const float gt = bf2f(R.gr[t]);
                const float v = H * gt * sigmoidf_(1.5957691216057308f * (gt + 0.044715f * gt * gt * gt));
                *(float*)(lds + LR_PV + (t * 512 + c) * 4) = v;
                sq[k] = v * v;
            } else {
                A *= a;
            }
        }
        if (FINAL) {
            const float tot = tr_reduce16(sq, lane & 15);
            if (lane < 16) ps[(tb + lane) * 8 + hh] = tot;
        }
    }
    if (FINAL) {
        __syncthreads();
#pragma unroll 4
        for (int t = 0; t < 32; ++t) {
            const f32x4 p0 = *(const f32x4*)(ps + t * 8), p1 = *(const f32x4*)(ps + t * 8 + 4);
            const float tot = (p0[0] + p0[1]) + (p0[2] + p0[3]) + (p1[0] + p1[1]) + (p1[2] + p1[3]);
            const float rs = __builtin_amdgcn_rsqf(tot * (1.f / 512.f) + 1e-5f);
            mixin[(t0 + t) * DM + c] = f2bf(*(const float*)(lds + LR_PV + (t * 512 + c) * 4) * rs * K.gv);
        }
    } else {
        aseg[(size_t)unit * 512 + c] = A;
        hseg[(size_t)unit * 512 + c] = H;
    }
}
template <bool FINAL>
__device__ __forceinline__ void lru2_units(int bid, int G, const bf16_t* __restrict__ h, const float* __restrict__ cw, const float* __restrict__ cb, const bf16_t* __restrict__ wT,
                                           const float* __restrict__ ba, const float* __restrict__ bx, const float* __restrict__ lam, const float* __restrict__ ng,
                                           float* __restrict__ aseg, float* __restrict__ hseg, bf16_t* __restrict__ mixin, unsigned char* lds) {
    if (bid >= 1024) return;
    LruConst K; lru2_const(K, cw, cb, ba, bx, lam, ng);
    LruRegs<FINAL> cur, nxt;
    lru2_load<FINAL>(bid, h, hseg, cur);
#pragma unroll 1
    for (int u = bid; u < 1024; u += G) {
        if (!(FINAL ? PF_LRU_T : PF_LRU_F) && u != bid) lru2_load<FINAL>(u, h, hseg, cur);
        lru2_front(cur.xr, K, wT, lds);
        if ((FINAL ? PF_LRU_T : PF_LRU_F) && u + G < 1024) lru2_load<FINAL>(u + G, h, hseg, nxt);
        lru2_back<FINAL>(u, cur, K, aseg, hseg, mixin, lds);
        if (FINAL ? PF_LRU_T : PF_LRU_F) cur = nxt;
    }
}
__device__ void lru2_carry(int vb, int tid, const float* __restrict__ aseg, float* __restrict__ hseg) {
    const int i = vb * 256 + tid;
    const int b = i >> 9, c = i & 511;
    float Hc = 0.f;
    for (int s0 = 0; s0 < 256; s0 += 8) {
        float av[8], hv[8];
#pragma unroll
        for (int k = 0; k < 8; ++k) { const size_t o = ((size_t)(b * 256 + s0 + k)) * 512 + c; av[k] = aseg[o]; hv[k] = hseg[o]; }
#pragma unroll
        for (int k = 0; k < 8; ++k) { const size_t o = ((size_t)(b * 256 + s0 + k)) * 512 + c; hseg[o] = Hc; Hc = fmaf(av[k], Hc, hv[k]); }
    }
}

struct EpiZ {
    static constexpr bool PERM = false, AFTER_DRAIN = false;
    bf16_t* Zb; const float* X; float* pstat; float alpha;
    __device__ __forceinline__ void operator()(const pg8::f32x4 (&acc)[2][2][4][2], const pg8::Unit& u, int wr, int wc, int fr, int fq) const {
        const int row0 = u.pm * pg8::BM + wr * 64 + fr, col0 = u.pn * pg8::BM + wc * 32 + 4 * fq;
#pragma unroll
        for (int ai = 0; ai < 2; ++ai)
#pragma unroll
            for (int m = 0; m < 4; ++m) {
                const int row = row0 + ai * pg8::HALF + m * 16;
                const size_t ro = (size_t)row * DM + col0;
                float s1 = 0.f, s2 = 0.f;
#pragma unroll
                for (int bj = 0; bj < 2; ++bj)
#pragma unroll
                    for (int n = 0; n < 2; ++n) {
                        const pg8::f32x4 xv = *(const pg8::f32x4*)(X + ro + bj * pg8::HALF + n * 16);
                        const pg8::f32x4 v = acc[ai][bj][m][n] + xv * alpha;
                        uint2 pk; pk.x = pack2bf(v[0], v[1]); pk.y = pack2bf(v[2], v[3]);
                        *(uint2*)(Zb + ro + bj * pg8::HALF + n * 16) = pk;
                        s1 += (v[0] + v[1]) + (v[2] + v[3]);
                        s2 += (v[0] * v[0] + v[1] * v[1]) + (v[2] * v[2] + v[3] * v[3]);
                    }
                s1 = xrow16_sum(s1); s2 = xrow16_sum(s2);
                if (fq == 0) { float2 st; st.x = s1; st.y = s2; *(float2*)(pstat + ((size_t)row * 16 + u.pn * 4 + wc) * 2) = st; }
            }
    }
};
struct EpiQ {
    static constexpr bool PERM = true, AFTER_DRAIN = false;
    bf16_t* O; int ldc; const float* stats; const float* c1; const float* c2;
    __device__ __forceinline__ void operator()(const pg8::f32x4 (&acc)[2][2][4][2], const pg8::Unit& u, int wr, int wc, int fr, int fq) const {
        const int row0 = u.pm * pg8::BM + wr * 64 + fr;
        const int col0 = u.pn * pg8::BM + wc * 32 + 8 * fq;
        pg8::f32x4 k1[2][2], k2[2][2];
#pragma unroll
        for (int bj = 0; bj < 2; ++bj)
#pragma unroll
            for (int n = 0; n < 2; ++n) { k1[bj][n] = *(const pg8::f32x4*)(c1 + col0 + bj * pg8::HALF + 4 * n); k2[bj][n] = *(const pg8::f32x4*)(c2 + col0 + bj * pg8::HALF + 4 * n); }
#pragma unroll
        for (int ai = 0; ai < 2; ++ai)
#pragma unroll
            for (int m = 0; m < 4; ++m) {
                const int row = row0 + ai * pg8::HALF + m * 16;
                const float2 st = *(const float2*)(stats + (size_t)row * 2);
                bf16_t* rowp = O + (size_t)row * ldc + col0;
#pragma unroll
                for (int bj = 0; bj < 2; ++bj) {
                    const pg8::f32x4 v0 = (acc[ai][bj][m][0] - k1[bj][0] * st.x) * st.y + k2[bj][0];
                    const pg8::f32x4 v1 = (acc[ai][bj][m][1] - k1[bj][1] * st.x) * st.y + k2[bj][1];
                    pg8::u32x4 w; w.x = pg8::cvt_pk_bf16(v0[0], v0[1]); w.y = pg8::cvt_pk_bf16(v0[2], v0[3]); w.z = pg8::cvt_pk_bf16(v1[0], v1[1]); w.w = pg8::cvt_pk_bf16(v1[2], v1[3]);
                    *(pg8::u32x4*)(rowp + bj * pg8::HALF) = w;
                }
            }
    }
};

#define XB_TMO      128
#define XB_XCNT(j)  (256  + 64 * (j))
#define XB_XSUB(j)  (1280 + 64 * (j))
#define XB_XGEN(j)  (2304 + 64 * (j))
#define XB_TOP      3328
#define XB_TOPGEN   3392
#define XCD_BAR_WORDS 3456
#define XB_SPIN_CAP (1u << 18)

__device__ __forceinline__ unsigned xb_ld(unsigned* p)              { return __hip_atomic_load(p, __ATOMIC_RELAXED, __HIP_MEMORY_SCOPE_AGENT); }
__device__ __forceinline__ unsigned xb_add(unsigned* p, unsigned v) { return __hip_atomic_fetch_add(p, v, __ATOMIC_RELAXED, __HIP_MEMORY_SCOPE_AGENT); }
__device__ __forceinline__ unsigned xb_xcc_id() { return (unsigned)__builtin_amdgcn_s_getreg((3 << 11) | 20) & 0xFu; }
#define XB_SPIN(cond, bar) do { unsigned _sp = 0; while (cond) { __builtin_amdgcn_s_sleep(1); \
    if ((++_sp & 255u) == 0u) { if (xb_ld(&(bar)[XB_TMO])) break; if (_sp > XB_SPIN_CAP) { atomicAdd(&(bar)[XB_TMO], 1u); break; } } } } while (0)

struct XcdBarrier {
    unsigned* bar; unsigned x;
    volatile LAS unsigned* st;
};

__device__ __forceinline__ XcdBarrier xcd_barrier_post(unsigned* bar, volatile LAS unsigned* st) {
    XcdBarrier b; b.bar = bar; b.x = xb_xcc_id(); b.st = st;
    if (threadIdx.x == 0) (void)xb_add(&bar[XB_XCNT(b.x)], 1u);
    return b;
}
__device__ __forceinline__ void xcd_barrier_complete(unsigned* bar, unsigned x, unsigned& nloc, unsigned& nx) {
    const unsigned G = gridDim.x * gridDim.y * gridDim.z;
    unsigned sum, cnt, mine, sp = 0u;
    for (;;) {
        sum = 0u; cnt = 0u; mine = 0u;
#pragma unroll
        for (unsigned j = 0; j < 16; ++j) { const unsigned c = xb_ld(&bar[XB_XCNT(j)]); sum += c; cnt += (c > 0u) ? 1u : 0u; mine = (j == x) ? c : mine; }
        if (sum == G) break;
        __builtin_amdgcn_s_sleep(1);
        if ((++sp & 255u) == 0u) { if (xb_ld(&bar[XB_TMO])) break; if (sp > XB_SPIN_CAP) { atomicAdd(&bar[XB_TMO], 1u); break; } }
    }
    nloc = mine > 0u ? mine : 1u; nx = cnt > 0u ? cnt : 1u;
}

__device__ __forceinline__ void xcd_barrier(const XcdBarrier& b) {
    asm volatile("s_waitcnt vmcnt(0)" ::: "memory");
    __syncthreads();
    if (threadIdx.x == 0) {
        unsigned* bar = b.bar;
        __builtin_amdgcn_s_waitcnt(0);
        unsigned nloc = b.st[0], nx = b.st[1];
        if (nloc == 0u) { xcd_barrier_complete(bar, b.x, nloc, nx); b.st[0] = nloc; b.st[1] = nx; }
        const unsigned old = xb_add(&bar[XB_XSUB(b.x)], 1u);
        const unsigned gen = old / nloc;
        if (old + 1u == (gen + 1u) * nloc) {
            __builtin_amdgcn_fence(__ATOMIC_RELEASE, "agent");
            asm volatile("s_waitcnt vmcnt(0)" ::: "memory");
            const unsigned og = xb_add(&bar[XB_TOP], 1u);
            const unsigned tg = og / nx;
            if (og + 1u == (tg + 1u) * nx) xb_add(&bar[XB_TOPGEN], 1u);
            else XB_SPIN(xb_ld(&bar[XB_TOPGEN]) == tg, bar);
            __builtin_amdgcn_fence(__ATOMIC_ACQUIRE, "agent");
            xb_add(&bar[XB_XGEN(b.x)], 1u);
            asm volatile("s_waitcnt vmcnt(0)" ::: "memory");
        } else {
            XB_SPIN(xb_ld(&bar[XB_XGEN(b.x)]) == gen, bar);
            __builtin_amdgcn_fence(__ATOMIC_ACQUIRE, "agent");
            asm volatile("s_waitcnt vmcnt(0)" ::: "memory");
        }
    }
    __syncthreads();
}


#define SL_TOKB 512
#define SL_NITEM (T_TOK / SL_TOKB)
__device__ __forceinline__ bool sl_next(unsigned* qw, int& s, int& tried, int& tb, volatile LAS unsigned* bc) {
    for (;;) {
        if (tried >= 8) return false;
        __syncthreads();
        if (threadIdx.x == 0) bc[0] = __hip_atomic_fetch_add(&qw[s], 1u, __ATOMIC_RELAXED, __HIP_MEMORY_SCOPE_AGENT);
        __syncthreads();
        const unsigned v = bc[0];
        if (v < (unsigned)SL_NITEM) { tb = (int)v; return true; }
        s = (s + 1) & 7; ++tried;
    }
}
template <int CTRL> __device__ __forceinline__ int dppi(int x) { return __builtin_amdgcn_mov_dpp(x, CTRL, 0xf, 0xf, true); }
#define SL_ISSUE(R, IA, IB) do { _Pragma("unroll") for (int i_ = 0; i_ < 16; ++i_) { \
        const int id_ = __shfl((i_ < 8) ? (IA) : (IB), (lane & ~7) | (i_ & 7)); \
        R[i_] = *(const u32x4*)(tabs + ((unsigned)id_ * 128u + coff)); } } while (0)
#define SL_META(T_, IA, IB, WA, WB, XV) do { const size_t o_ = (size_t)(T_) * 128 + 16 * g + ci; IA = idx[o_]; IB = idx[o_ + 8]; \
        if (IS_V) { WA = aux[o_]; WB = aux[o_ + 8]; } \
        else { XV[0] = __builtin_bit_cast(f32x4, *(const u32x4*)((const unsigned char*)zbf + (size_t)(T_) * DM + s * 128 + ci * 16)); } } while (0)
template <bool IS_V>
__device__ __forceinline__ void sl_compute(const u32x4 (&R)[16], int t, int s, int lane, int g, int ci, float wa, float wb, const f32x4 (&xq)[4], float* __restrict__ outp) {
    if (!IS_V) {
        const int zq0 = (int)__float_as_uint(xq[0][0]), zq1 = (int)__float_as_uint(xq[0][1]), zq2 = (int)__float_as_uint(xq[0][2]), zq3 = (int)__float_as_uint(xq[0][3]);
        float pr[16];
#pragma unroll
        for (int i = 0; i < 16; ++i) {
            int acc = __builtin_amdgcn_sdot4((int)R[i].x, zq0, 0, false);
            acc = __builtin_amdgcn_sdot4((int)R[i].y, zq1, acc, false);
            acc = __builtin_amdgcn_sdot4((int)R[i].z, zq2, acc, false);
            acc = __builtin_amdgcn_sdot4((int)R[i].w, zq3, acc, false);
            pr[i] = (float)acc;
        }
#define DPP_ADD(dst, x, CTRLSTR) asm volatile("s_nop 1\n\tv_add_f32_dpp %0, %1, %1 " CTRLSTR " row_mask:0xf bank_mask:0xf bound_ctrl:1" : "=&v"(dst) : "v"(x))
#define TR8_STEP(HALF, CTRLSTR, BIT) _Pragma("unroll") for (int h_ = 0; h_ < (HALF); ++h_) { \
            const float lo_ = pr[h_], hi_ = pr[h_ + (HALF)]; float t1_, t2_; DPP_ADD(t1_, lo_, CTRLSTR); DPP_ADD(t2_, hi_, CTRLSTR); \
            pr[h_] = (ci & (BIT)) ? t2_ : t1_; }
        TR8_STEP(8, "row_half_mirror", 4) TR8_STEP(4, "quad_perm:[2,3,0,1]", 2) TR8_STEP(2, "quad_perm:[1,0,3,2]", 1)
#undef TR8_STEP
#undef DPP_ADD
        *(unsigned*)((bf16_t*)outp + ((size_t)s * T_TOK + t) * 128 + 16 * g + 8 * ((ci >> 2) & 1) + 4 * ((ci >> 1) & 1) + 2 * (ci & 1)) = pack2bf(pr[0], pr[1]);
    } else {
        f32x2_t y2[8];
#pragma unroll
        for (int i = 0; i < 8; ++i) y2[i] = (f32x2_t){0.f, 0.f};
#pragma unroll
        for (int i = 0; i < 16; ++i) {
            const float w_ = __shfl((i < 8) ? wa : wb, (lane & ~7) | (i & 7));
            const f32x2_t w2 = {w_, w_};
            y2[0] = __builtin_amdgcn_cvt_pk_f32_fp8((int)R[i].x, false) * w2 + y2[0];
            y2[1] = __builtin_amdgcn_cvt_pk_f32_fp8((int)R[i].x, true) * w2 + y2[1];
            y2[2] = __builtin_amdgcn_cvt_pk_f32_fp8((int)R[i].y, false) * w2 + y2[2];
            y2[3] = __builtin_amdgcn_cvt_pk_f32_fp8((int)R[i].y, true) * w2 + y2[3];
            y2[4] = __builtin_amdgcn_cvt_pk_f32_fp8((int)R[i].z, false) * w2 + y2[4];
            y2[5] = __builtin_amdgcn_cvt_pk_f32_fp8((int)R[i].z, true) * w2 + y2[5];
            y2[6] = __builtin_amdgcn_cvt_pk_f32_fp8((int)R[i].w, false) * w2 + y2[6];
            y2[7] = __builtin_amdgcn_cvt_pk_f32_fp8((int)R[i].w, true) * w2 + y2[7];
        }
        float y[16];
#pragma unroll
        for (int i = 0; i < 8; ++i) { y[2 * i] = y2[i].x; y[2 * i + 1] = y2[i].y; }
#pragma unroll
        for (int h = 0; h < 8; ++h) {
            const float lo_ = y[h], hi_ = y[h + 8]; const float t1_ = lo_ + dppf<DPP_XOR8>(lo_), t2_ = hi_ + dppf<DPP_XOR8>(hi_);
            y[h] = (lane & 8) ? t2_ : t1_;
        }
#pragma unroll
        for (int h = 0; h < 4; ++h) {
            auto sw = __builtin_amdgcn_permlane16_swap(__float_as_uint(y[h]), __float_as_uint(y[h + 4]), false, false);
            y[h] = __uint_as_float(sw[0]) + __uint_as_float(sw[1]);
        }
#pragma unroll
        for (int h = 0; h < 2; ++h) {
            auto sw = __builtin_amdgcn_permlane32_swap(__float_as_uint(y[h]), __float_as_uint(y[h + 2]), false, false);
            y[h] = __uint_as_float(sw[0]) + __uint_as_float(sw[1]);
        }
        *(unsigned*)((bf16_t*)outp + (size_t)t * DM + s * 128 + ci * 16 + 8 * ((lane >> 3) & 1) + 4 * ((lane >> 4) & 1) + 2 * ((lane >> 5) & 1)) = pack2bf(y[0], y[1]);
    }
}
template <bool IS_V>
__device__ void slice_phase(const float* __restrict__ aux, const bf16_t* __restrict__ zbf, const int* __restrict__ idx, const unsigned char* __restrict__ tab8s, float* __restrict__ outp, unsigned* qw, unsigned char* lds) {
    const int tx = opaque_tid();
    const int lane = tx & 63, w = tx >> 6;
    const int g = lane >> 3, ci = lane & 7;
    constexpr int NT = SL_TOKB / 8;
    volatile LAS unsigned* bc = (volatile LAS unsigned*)(lds + LDS_BYTES - 32);
    int s = (int)xb_xcc_id() & 7, tried = 0, tb = 0;
    while (sl_next(qw, s, tried, tb, bc)) {
        const unsigned char* tabs = tab8s + (size_t)s * (16384 * 128);
        const unsigned coff = (unsigned)ci * 16u;
        const int tbase = tb * SL_TOKB + w * NT;
        u32x4 RA[16], RB[16];
        int ia0, ib0, ia1, ib1; float wa0 = 0.f, wb0 = 0.f, wa1 = 0.f, wb1 = 0.f; f32x4 xq0[4], xq1[4];
        SL_META(tbase, ia0, ib0, wa0, wb0, xq0);
        SL_META(tbase + 1, ia1, ib1, wa1, wb1, xq1);
        SL_ISSUE(RA, ia0, ib0);
#pragma unroll 2
        for (int k = 0; k < NT; k += 2) {
            SL_ISSUE(RB, ia1, ib1);
            const float cwa = wa0, cwb = wb0; f32x4 cx[4];
#pragma unroll
            for (int i = 0; i < 4; ++i) cx[i] = xq0[i];
            if (k + 2 < NT) SL_META(tbase + k + 2, ia0, ib0, wa0, wb0, xq0);
            sl_compute<IS_V>(RA, tbase + k, s, lane, g, ci, cwa, cwb, cx, outp);
            if (k + 2 < NT) SL_ISSUE(RA, ia0, ib0);
            const float dwa = wa1, dwb = wb1; f32x4 dx[4];
#pragma unroll
            for (int i = 0; i < 4; ++i) dx[i] = xq1[i];
            if (k + 3 < NT) SL_META(tbase + k + 3, ia1, ib1, wa1, wb1, xq1);
            sl_compute<IS_V>(RB, tbase + k + 1, s, lane, g, ci, dwa, dwb, dx, outp);
        }
    }
}
__device__ void slice_combine_phase(const float* __restrict__ pd, const int* __restrict__ idx, float* __restrict__ gatew, const float* __restrict__ iu, const float* __restrict__ iv,
                                    const float* __restrict__ stats, const float* __restrict__ cu1, const float* __restrict__ cu2, const float* __restrict__ zsc) {
    for (size_t i = (size_t)blockIdx.x * NTHR + threadIdx.x; i < (size_t)T_TOK * 128; i += (size_t)gridDim.x * NTHR) {
        float sacc = 0.f;
#pragma unroll
        for (int s = 0; s < 8; ++s) sacc += bf2f(((const bf16_t*)pd)[(size_t)s * T_TOK * 128 + i]);
        const int id = idx[i];
        const float2 st = *(const float2*)(stats + (i >> 7) * 2);
        gatew[i] = gelu_as(st.y * (sacc * (iu[id] * zsc[i >> 7]) - st.x * cu1[id]) + cu2[id]) * gatew[i] * iv[id];
    }
}
__device__ void ln2_phase(float* __restrict__ x1io, const bf16_t* __restrict__ zbf, const float* __restrict__ ysl, const float* __restrict__ g, const float* __restrict__ bb,
                          const float* __restrict__ stats, const float* __restrict__ g1, const float* __restrict__ b1) {
    const int tx = opaque_tid();
    const int lane = tx & 63;
    const int gw = blockIdx.x * (NTHR / 64) + (tx >> 6);
    const int nw = gridDim.x * (NTHR / 64);
    for (int t = gw; t < T_TOK; t += nw) {
        float* xr = x1io + (size_t)t * DM + 16 * lane;
        const bf16_t* yr = (const bf16_t*)ysl + (size_t)t * DM + 16 * lane;
        float v[16];
        const float2 st = *(const float2*)(stats + (size_t)t * 2);
#pragma unroll
        for (int i = 0; i < 4; ++i) {
            int off1 = 16 * lane + 4 * i;
            asm volatile("" : "+v"(off1));
            const uint2 zp = *(const uint2*)(zbf + (size_t)t * DM + 16 * lane + 4 * i);
            const f32x4 a = {__uint_as_float(zp.x << 16), __uint_as_float(zp.x & 0xffff0000u), __uint_as_float(zp.y << 16), __uint_as_float(zp.y & 0xffff0000u)};
            const uint2 yp = *(const uint2*)(yr + 4 * i);
            const f32x4 y4 = {__uint_as_float(yp.x << 16), __uint_as_float(yp.x & 0xffff0000u), __uint_as_float(yp.y << 16), __uint_as_float(yp.y & 0xffff0000u)};
            const f32x4 g14 = *(const f32x4*)(g1 + off1), b14 = *(const f32x4*)(b1 + off1);
#pragma unroll
            for (int k = 0; k < 4; ++k) v[4 * i + k] = ALPHA * ((a[k] - st.x) * st.y * g14[k] + b14[k]) + y4[k];
        }
        float sm = 0.f;
#pragma unroll
        for (int i = 0; i < 16; ++i) sm += v[i];
        const float mu = wave_sum(sm) * (1.f / 1024.f);
        float qq = 0.f;
#pragma unroll
        for (int i = 0; i < 16; ++i) { const float d = v[i] - mu; qq += d * d; }
        const float rs = __builtin_amdgcn_rsqf(wave_sum(qq) * (1.f / 1024.f) + 1e-5f);
#pragma unroll
        for (int i = 0; i < 4; ++i) {
            int off = 16 * lane + 4 * i;
            asm volatile("" : "+v"(off));
            const f32x4 gv = *(const f32x4*)(g + off), bv = *(const f32x4*)(bb + off);
            f32x4 o;
#pragma unroll
            for (int k = 0; k < 4; ++k) o[k] = (v[4 * i + k] - mu) * rs * gv[k] + bv[k];
            *(f32x4*)(xr + 4 * i) = o;
        }
    }
}

struct Params {
    const float* in[21];
    float* out;
    char* ws;
    int nrep_gather;
    int probe;
};

#define WS_XB      0
#define WS_WIN     64
#define WS_WOUT    70
#define WS_WQ      72
#define WS_SK      76
#define WS_UT      80
#define WS_VT      112
#define WS_H       144
#define WS_X1B     272
#define WS_XC      340
#define WS_ITOP    372
#define WS_IDX     404
#define WS_GATE    420
#define WS_KV      436
#define WS_GAM     500
#define WS_ASEG    501
#define WS_HSEG    503
#define WS_DBG     505
#define WS_BAR     506
#define WS_LRUW    507
#define WS_PSTAT   508
#define WS_END     512
#ifndef DEBUG_HG
#define DEBUG_HG 0
#endif

__global__ void __launch_bounds__(NTHR, 2) mega(Params p) {
    extern __shared__ __attribute__((aligned(16))) unsigned char lds[];
    if (threadIdx.x < 4) ((volatile LAS unsigned*)(lds + LDS_BYTES - 16))[threadIdx.x] = 0u;
    __syncthreads();
    const XcdBarrier gbar = xcd_barrier_post((unsigned*)(p.ws + (size_t)WS_BAR * 1024 * 1024), (volatile LAS unsigned*)(lds + LDS_BYTES - 16));
    const float* x = p.in[0];
    const float* w_in = p.in[1];
    const float* conv_w = p.in[2];
    const float* conv_b = p.in[3];
    const float* lru_wa = p.in[4];
    const float* lru_ba = p.in[5];
    const float* lru_wx = p.in[6];
    const float* lru_bx = p.in[7];
    const float* lru_lam = p.in[8];
    const float* lru_ng = p.in[9];
    const float* lbl = p.in[10];
    const float* hg_ng = p.in[11];
    const float* w_out = p.in[12];
    const float* ln1_g = p.in[13];
    const float* ln1_b = p.in[14];
    const float* wq = p.in[15];
    const float* subk = p.in[16];
    const float* ut = p.in[17];
    const float* vt = p.in[18];
    const float* ln2_g = p.in[19];
    const float* ln2_b = p.in[20];
    float* out = p.out;
    char* ws = p.ws;
    const size_t MB = 1024 * 1024;
    bf16_t* xb = (bf16_t*)(ws + WS_XB * MB);
    bf16_t* mixin = (bf16_t*)(ws + WS_XB * MB);
    bf16_t* w_inT = (bf16_t*)(ws + WS_WIN * MB);
    bf16_t* w_outT = (bf16_t*)(ws + WS_WOUT * MB);
    bf16_t* wqT = (bf16_t*)(ws + WS_WQ * MB);
    bf16_t* utb = (bf16_t*)(ws + WS_UT * MB);
    bf16_t* skb = (bf16_t*)(ws + WS_SK * MB);
    unsigned char* u8 = (unsigned char*)(ws + WS_UT * MB);
    unsigned char* v8 = (unsigned char*)(ws + WS_VT * MB);
    float* iu = (float*)(ws + (WS_UT + 16) * MB);
    float* iv = (float*)(ws + (WS_VT + 16) * MB);
    float* cu1 = iu + 16384;
    float* cu2 = iu + 2 * 16384;
    float* qc1 = (float*)(ws + 77 * MB);
    float* qc2 = qc1 + 2048;
    float* stats = (float*)(ws + 77 * MB + 65536);
    float* qc1p = (float*)(ws + 78 * MB);
    float* qc2p = qc1p + 16 * 2048;
    float* pstat = (float*)(ws + (size_t)WS_PSTAT * MB);
    unsigned char* zq = (unsigned char*)(ws + (size_t)WS_XC * MB);
    float* zsc = (float*)(ws + (size_t)(WS_XC + 32) * MB);
    bf16_t* vtb = (bf16_t*)(ws + WS_VT * MB);
    bf16_t* h = (bf16_t*)(ws + WS_H * MB);
    float* z = (float*)(ws + WS_H * MB);
    bf16_t* q = (bf16_t*)(ws + WS_H * MB);
    bf16_t* x1b = (bf16_t*)(ws + WS_X1B * MB);
    float* xc = (float*)(ws + WS_XC * MB);
    float* s_top = (float*)(ws + WS_XC * MB);
    int* i_top = (int*)(ws + WS_ITOP * MB);
    int* idx = (int*)(ws + WS_IDX * MB);
    float* gate = (float*)(ws + WS_GATE * MB);
    bf16_t* kvb = (bf16_t*)(ws + WS_KV * MB);
    float* gam = (float*)(ws + WS_GAM * MB);
    float* dbg = (float*)(ws + WS_DBG * MB);
    float* aseg = (float*)(ws + WS_ASEG * MB);
    float* hseg = (float*)(ws + WS_HSEG * MB);
    bf16_t* lruwT = (bf16_t*)(ws + WS_LRUW * MB);
    bf16_t* mixin2 = (bf16_t*)(ws + WS_XC * MB);
    float* a_arr = out;
    float* u_arr = out + (size_t)T_TOK * 512;
    const int G = gridDim.x, bid = blockIdx.x;
    const int half = threadIdx.x >> 8, tid = threadIdx.x & 255;
    float* smf = (float*)lds;
    if (bid == 0 && threadIdx.x == 0) { dbg[0] = 0.f; dbg[1] = 0.f; }

#define REPEAT(k) _Pragma("unroll 1") for (int rp_ = (p.probe == (k) || ((k) == 4 && p.probe == 9)) ? 1 : 0; rp_ >= 0; --rp_)
    REPEAT(1) {
    for (int u = bid; u < T_TOK * DM / 4096; u += G) cvt_unit(u, x, xb);
    for (int u = bid; u < 64; u += G) cvt_unit(u, subk, skb);
    for (int e = bid * NTHR + threadIdx.x; e < 2 * 8 * 64 * 64; e += G * NTHR) {
        const int i_ = e & 63, j_ = (e >> 6) & 63, hh_ = (e >> 12) & 7, g_ = e >> 15;
        lruwT[e] = f2bf((g_ ? lru_wx : lru_wa)[(hh_ * 64 + i_) * 64 + j_]);
    }
    for (int u = bid; u < 16 * 48 + 16 * 16 + 16 * 32; u += G) {
        if (u < 768) transpose_unit(u, w_in, w_inT, 1024, 3072, smf);
        else if (u < 768 + 256) transpose_unit(u - 768, w_out, w_outT, 1024, 1024, smf);
        else transpose_unit(u - 1024, wq, wqT, 1024, 2048, smf, ln1_g, ln1_b, qc1p, qc2p);
    }
    }
    xcd_barrier(gbar);
    REPEAT(2) {
        pg8::Gemm g{xb, w_inT, T_TOK, INW, DM}; pg8::StaticOrder S; S.init(T_TOK, INW, G, bid);
        EpiBf16 E{h, INW};
        pg8::gemm_phase<EpiBf16, pg8::StaticOrder, false>((PG8_LAS unsigned char*)lds, g, S, E, nullptr);
    }
    xcd_barrier(gbar);
    {
        lru2_units<false>(bid, G, h, conv_w, conv_b, lruwT, lru_ba, lru_bx, lru_lam, lru_ng, aseg, hseg, mixin, lds);
        if (bid < 2048) {
            float lb4[2][4];
            { const int d_ = 2 * (opaque_tid() & 63);
#pragma unroll
              for (int k = 0; k < 4; ++k) { lb4[0][k] = hg_lb(lbl, k * 128 + d_); lb4[1][k] = hg_lb(lbl, k * 128 + d_ + 1); } }
            HgP2Regs cur, nxt;
            hgrn_p2_load(bid, h, cur);
#pragma unroll 1
            for (int u = bid; u < 2048; u += G) {
                if (!PF_HG2 && u != bid) hgrn_p2_load(u, h, cur);
                if (PF_HG2 && u + G < 2048) hgrn_p2_load(u + G, h, nxt);
                hgrn_p2_body(u, cur, lb4, kvb, gam, lds);
                if (PF_HG2) cur = nxt;
            }
        }
    }
    xcd_barrier(gbar);
    if (threadIdx.x < 256) {
        hgrn_scan4(threadIdx.x, kvb, gam);
        if (bid < 8) lru2_carry(bid, threadIdx.x, aseg, hseg);
    } else {
        for (int r = bid * 4 + ((threadIdx.x - 256) >> 6); r < 2 * 16384; r += G * 4) {
            if (r < 16384) quant_row(ut, u8, iu, r, threadIdx.x & 63, ln1_g, ln1_b, cu1, cu2, true); else quant_row(vt, v8, iv, r - 16384, threadIdx.x & 63);
        }
    }
    xcd_barrier(gbar);
    {
        lru2_units<true>(bid, G, h, conv_w, conv_b, lruwT, lru_ba, lru_bx, lru_lam, lru_ng, aseg, hseg, mixin, lds);
        if (bid < 2048) {
            float lb4[2][4], gn4[4];
            { const int d_ = 2 * (opaque_tid() & 63), e_ = (opaque_tid() & 31) + 32 * ((opaque_tid() >> 6) & 3);
#pragma unroll
              for (int k = 0; k < 4; ++k) { lb4[0][k] = hg_lb(lbl, k * 128 + d_); lb4[1][k] = hg_lb(lbl, k * 128 + d_ + 1); gn4[k] = hg_ng[k * 128 + e_]; } }
            HgP4Regs cur, nxt;
            hgrn_p4_load(bid, h, kvb, cur);
#pragma unroll 1
            for (int u = bid; u < 2048; u += G) {
                if (!PF_HG4 && u != bid) hgrn_p4_load(u, h, kvb, cur);
                if (PF_HG4 && u + G < 2048) hgrn_p4_load(u + G, h, kvb, nxt);
                hgrn_p4_body(u, cur, lb4, gn4, mixin, lds);
                if (PF_HG4) cur = nxt;
            }
        }
    }
    xcd_barrier(gbar);
    REPEAT(5) {
        pg8::Gemm g{mixin, w_outT, T_TOK, DM, DM}; pg8::StaticOrder S; S.init(T_TOK, DM, G, bid);
        EpiZ E{x1b, x, pstat, ALPHA};
        pg8::gemm_phase<EpiZ, pg8::StaticOrder, false>((PG8_LAS unsigned char*)lds, g, S, E, nullptr);
    }
    xcd_barrier(gbar);
    for (int n = bid * NTHR + threadIdx.x; n < 2048; n += G * NTHR) {
        float s1 = 0.f, s2 = 0.f;
#pragma unroll
        for (int kt = 0; kt < 16; ++kt) { s1 += qc1p[kt * 2048 + n]; s2 += qc2p[kt * 2048 + n]; }
        qc1[n] = s1; qc2[n] = s2;
    }
    for (int t = bid * (NTHR / 64) + (threadIdx.x >> 6); t < T_TOK; t += G * (NTHR / 64)) {
        const int ln = threadIdx.x & 63;
        const u32x4* zp = (const u32x4*)(x1b + (size_t)t * DM + 16 * ln);
        const u32x4 z0 = zp[0], z1 = zp[1];
        const unsigned zw[8] = {z0.x, z0.y, z0.z, z0.w, z1.x, z1.y, z1.z, z1.w};
        float zf[16]; float m = 0.f;
#pragma unroll
        for (int k = 0; k < 8; ++k) { zf[2 * k] = __uint_as_float(zw[k] << 16); zf[2 * k + 1] = __uint_as_float(zw[k] & 0xffff0000u); m = fmaxf(m, fmaxf(fabsf(zf[2 * k]), fabsf(zf[2 * k + 1]))); }
#pragma unroll
        for (int o = 32; o > 0; o >>= 1) m = fmaxf(m, __shfl_xor(m, o));
        const float sc = m > 0.f ? 127.f / m : 1.f;
        u32x4 wq4;
#pragma unroll
        for (int k = 0; k < 4; ++k) wq4[k] = pack_i8x4(zf[4 * k] * sc, zf[4 * k + 1] * sc, zf[4 * k + 2] * sc, zf[4 * k + 3] * sc);
        *(u32x4*)(zq + (size_t)t * DM + 16 * ln) = wq4;
        if (ln == 0) zsc[t] = m > 0.f ? m / 127.f : 1.f;
    }
    for (int t = bid * NTHR + threadIdx.x; t < T_TOK; t += G * NTHR) {
        const f32x4* pp = (const f32x4*)(pstat + (size_t)t * 32);
        float s1 = 0.f, s2 = 0.f;
#pragma unroll
        for (int i = 0; i < 8; ++i) { const f32x4 v = pp[i]; s1 += v[0] + v[2]; s2 += v[1] + v[3]; }
        const float mu = s1 * (1.f / 1024.f);
        float2 st; st.x = mu; st.y = __builtin_amdgcn_rsqf(fmaxf(s2 * (1.f / 1024.f) - mu * mu, 0.f) + 1e-5f);
        *(float2*)(stats + (size_t)t * 2) = st;
    }
    xcd_barrier(gbar);
    REPEAT(7) {
        pg8::Gemm g{x1b, wqT, T_TOK, 2048, DM}; pg8::StaticOrder S; S.init(T_TOK, 2048, G, bid);
        EpiQ E{q, 2048, stats, qc1, qc2};
        pg8::gemm_phase<EpiQ, pg8::StaticOrder, false>((PG8_LAS unsigned char*)lds, g, S, E, nullptr);
    }
    xcd_barrier(gbar);
    REPEAT(8) topk_phase(q, skb, idx, gate, lds);
    xcd_barrier(gbar);
#if PEER_SLICED
    {
        unsigned* qw = (unsigned*)(p.ws + (size_t)WS_BAR * 1024 * 1024) + XCD_BAR_WORDS;
        float* pd = (float*)(ws + WS_H * MB);
        slice_phase<false>(nullptr, (const bf16_t*)zq, idx, u8, pd, qw, lds);
        xcd_barrier(gbar);
        slice_combine_phase(pd, idx, gate, iu, iv, stats, cu1, cu2, zsc);
        xcd_barrier(gbar);
        slice_phase<true>(gate, nullptr, idx, v8, pd, qw + 8, lds);
        xcd_barrier(gbar);
        ln2_phase(out, x1b, pd, ln2_g, ln2_b, stats, ln1_g, ln1_b);
    }
#else
#pragma unroll 1
    for (int rp = p.nrep_gather; rp >= 0; --rp)
        gather8_phase(out, rp ? (float*)(ws + WS_H * MB) : out, idx, gate, u8, v8, iu, iv, ln2_g, ln2_b);
#endif
}

extern "C" void kernel_launch(void* const* d_in, const int* in_sizes, int n_in, void* d_out, int out_size, void* d_ws, size_t ws_size, hipStream_t stream) {
    static int grid_blocks = 0;
    if (!grid_blocks) {
        int dev = 0, cus = 0, per_cu = 0;
        (void)hipGetDevice(&dev);
        (void)hipDeviceGetAttribute(&cus, hipDeviceAttributeMultiprocessorCount, dev);
        if (hipFuncSetAttribute((const void*)mega, hipFuncAttributeMaxDynamicSharedMemorySize, LDS_BYTES) != hipSuccess) { fprintf(stderr, "hipFuncSetAttribute failed\n"); return; }
        (void)hipOccupancyMaxActiveBlocksPerMultiprocessor(&per_cu, mega, NTHR, LDS_BYTES);
        if (per_cu < 1) { fprintf(stderr, "occupancy query says %d\n", per_cu); return; }
        grid_blocks = cus;
    }
    if (ws_size < (size_t)WS_END * 1024 * 1024 || n_in != 21) { fprintf(stderr, "ws too small %zu or n_in %d\n", ws_size, n_in); return; }
    Params p{};
    for (int i = 0; i < 21; i++) p.in[i] = (const float*)d_in[i];
    p.out = (float*)d_out;
    p.ws = (char*)d_ws;
    p.nrep_gather = PROBE_NREP;
    p.probe = PROBE_PHASE;
    if (hipMemsetAsync((char*)d_ws + (size_t)WS_BAR * 1024 * 1024, 0, (XCD_BAR_WORDS + 16) * 4, stream) != hipSuccess) { fprintf(stderr, "memset of barrier words failed\n"); return; }
    void* args[] = {&p};
    hipError_t e = hipLaunchCooperativeKernel((void*)mega, dim3(grid_blocks), dim3(NTHR), args, LDS_BYTES, stream);
    if (e != hipSuccess) fprintf(stderr, "cooperative launch failed: %s (grid %d)\n", hipGetErrorString(e), grid_blocks);
}
```

```cpp
#include <hip/hip_runtime.h>
#include <hip/hip_cooperative_groups.h>
#include <cstdio>
#include <cstdint>
namespace cg = cooperative_groups;

#ifndef PEER_SLICED
#define PEER_SLICED 1
#endif
#ifndef PROBE_PHASE
#define PROBE_PHASE 0
#endif
#ifndef PROBE_NREP
#define PROBE_NREP 0
#endif
#define T_TOK 32768
#define SEQ 8192
#define DM 1024
#define INW 3072
#define NTHR 512
#define LDS_BYTES (144 * 1024)
#define ALPHA 1.189207115002721f
#define LAS __attribute__((address_space(3)))

namespace pg8 {
#define PG8_LAS __attribute__((address_space(3)))
typedef unsigned short bf16_t;
typedef short bf16x8 __attribute__((ext_vector_type(8)));
typedef float f32x4 __attribute__((ext_vector_type(4)));
typedef unsigned u32x4 __attribute__((ext_vector_type(4)));
constexpr int BM = 256, BK = 64, HALF = 128, HTB = HALF * BK * 2  , STAGE_BYTES = 8 * HTB, NXCD = 8, WGM = 8;

__host__ __device__ __forceinline__ int lds_byte(int r, int c) { const int st = (r >> 4) * 2 + (c >> 5), rr = r & 15, cc = c & 31, ob = rr * 64 + cc * 2; return st * 1024 + (ob ^ (((ob >> 9) & 1) << 5)); }
__host__ __device__ __forceinline__ void stage_rc(int b, int& R, int& C) { const int st = b / 1024, sb = b % 1024, swz = sb ^ (((sb >> 9) & 1) << 5); R = (st >> 1) * 16 + swz / 64; C = (st & 1) * 32 + (swz % 64) / 2; }
__host__ __device__ __forceinline__ int perm32(int rho) { const int n = rho >> 4, i = rho & 15; return 8 * (i >> 2) + 4 * n + (i & 3); }

struct Unit { int pm, pn; };
struct Gemm { const bf16_t* A; const bf16_t* Bt; int M, N, K; };

struct StaticOrder {
    int nM, nN, nwg, G, c;
    __host__ __device__ void init(int M, int N, int G_, int c_) { nM = M / BM; nN = N / BM; nwg = nM * nN; G = G_; c = c_; }
    __host__ __device__ bool next(int i, Unit& u) const {
        const long L = (long)i * G + c; if (L >= nwg) return false;
        int wgid = (int)L; { const int q = nwg / NXCD, r = nwg % NXCD, xcd = wgid % NXCD, off = wgid / NXCD; wgid = (xcd < r ? xcd * (q + 1) : r * (q + 1) + (xcd - r) * q) + off; }
        const int nig = WGM * nN, gid = wgid / nig, fm = gid * WGM, gsz = (nM - fm) < WGM ? (nM - fm) : WGM;
        u.pm = fm + ((wgid % nig) % gsz); u.pn = (wgid % nig) / gsz; return true;
    }
    __device__ __forceinline__ void a_ready(const Unit&) const {}
    __device__ __forceinline__ void done(const Unit&) const {}
};
typedef __bf16 bf16x2c_t __attribute__((ext_vector_type(2))); typedef float f32x2c_t __attribute__((ext_vector_type(2)));
__device__ __forceinline__ unsigned cvt_pk_bf16(float lo, float hi) { return __builtin_bit_cast(unsigned, __builtin_convertvector((f32x2c_t){lo, hi}, bf16x2c_t)); }
typedef float f32x2 __attribute__((ext_vector_type(2)));
template <class Epi, class Sched, bool STAMP = false>
__device__ __forceinline__ void gemm_phase(PG8_LAS unsigned char* lds, const Gemm g, const Sched& S, const Epi& E, unsigned long long* stamps) {
    int tid = threadIdx.x; asm volatile("" : "+v"(tid)); const int wid = __builtin_amdgcn_readfirstlane(tid >> 6), lane = tid & 63, wr = wid >> 2, wc = wid & 3, fr = lane & 15, fq = lane >> 4;
    const int K = g.K, nt = K / BK;
    int ts_lo = 0, ts_hi = 0, nts = 0; const unsigned long long rt_entry = STAMP ? (unsigned long long)wall_clock64() : 0ull;
#define PG8_STAMP() do { if (STAMP && wid == 0 && nts < 64) { const unsigned long long _c = (unsigned long long)clock64(); \
        ts_lo = (lane == nts) ? (int)(unsigned)_c : ts_lo; ts_hi = (lane == nts) ? (int)(unsigned)(_c >> 32) : ts_hi; ++nts; } } while (0)
    PG8_STAMP();
    unsigned voffA[2], voffB[2];
#pragma unroll
    for (int i = 0; i < 2; ++i) { int R, C; stage_rc(tid * 16 + i * 8192, R, C); const int Rb = Epi::PERM ? ((R & ~31) + perm32(R & 31)) : R;
        voffA[i] = (unsigned)(R * K + C) * 2u; voffB[i] = (unsigned)(Rb * K + C) * 2u; }
    const size_t kstep = (size_t)(BK * 2);
    const size_t hstep = (size_t)HALF * K * 2;
    const size_t tstep = 2 * hstep;
    const unsigned ldsw = (unsigned)wid * 1024u;
    const int aoff = lds_byte(wr * 64 + fr, fq * 8), boff = lds_byte(wc * 32 + fr, fq * 8);
#define PG8_SA(b, h) (((b) * 2 + (h)) * HTB)
#define PG8_SB(b, h) ((4 + (b) * 2 + (h)) * HTB)
#define PG8_STAGE(bufoff, gbase, voff) do { _Pragma("unroll") for (int _i = 0; _i < 2; ++_i) \
        __builtin_amdgcn_global_load_lds((const unsigned*)((const char*)(gbase) + (voff)[_i]), (PG8_LAS unsigned*)(lds + (bufoff) + ldsw + _i * 8192), 16, 0, 0); } while (0)
#define PG8_LDA(dst, b, h) do { _Pragma("unroll") for (int m = 0; m < 4; ++m) _Pragma("unroll") for (int k = 0; k < 2; ++k) dst[m][k] = *(const PG8_LAS bf16x8*)(lds + PG8_SA(b, h) + aoff + m * 2048 + k * 1024); } while (0)
#define PG8_LDB(dst, b, h) do { _Pragma("unroll") for (int n = 0; n < 2; ++n) _Pragma("unroll") for (int k = 0; k < 2; ++k) dst[n][k] = *(const PG8_LAS bf16x8*)(lds + PG8_SB(b, h) + boff + n * 2048 + k * 1024); } while (0)
#define PG8_MMA(ai, bj, At, Bt) do { __builtin_amdgcn_s_setprio(1); _Pragma("unroll") for (int m = 0; m < 4; ++m) _Pragma("unroll") for (int n = 0; n < 2; ++n) _Pragma("unroll") for (int k = 0; k < 2; ++k) \
        acc[ai][bj][m][n] = __builtin_amdgcn_mfma_f32_16x16x32_bf16(Bt[n][k], At[m][k], acc[ai][bj][m][n], 0, 0, 0); __builtin_amdgcn_s_setprio(0); } while (0)
#define PG8_WAIT_V(n) asm volatile("s_waitcnt vmcnt(" #n ")" ::: "memory")
#define PG8_WAIT_L(n) asm volatile("s_waitcnt lgkmcnt(" #n ")" ::: "memory")
#define PG8_BAR __builtin_amdgcn_s_barrier()
#define PG8_SCHED __builtin_amdgcn_sched_barrier(0)
    Unit cur, nxt; int ui = 0;
    if (!S.next(0, cur)) return;
    f32x4 acc[2][2][4][2];
#pragma unroll
    for (int a = 0; a < 2; ++a)
#pragma unroll
        for (int b = 0; b < 2; ++b)
#pragma unroll
            for (int m = 0; m < 4; ++m)
#pragma unroll
                for (int n = 0; n < 2; ++n) acc[a][b][m][n] = (f32x4){0.f, 0.f, 0.f, 0.f};
    bf16x8 At[4][2], B0[2][2], B1[2][2];
    const char* cA = (const char*)g.A + (size_t)cur.pm * tstep; const char* cB = (const char*)g.Bt + (size_t)cur.pn * tstep;
    S.a_ready(cur);
    PG8_STAGE(PG8_SB(0, 0), cB, voffB); PG8_STAGE(PG8_SA(0, 0), cA, voffA); PG8_STAGE(PG8_SB(0, 1), cB + hstep, voffB); PG8_STAGE(PG8_SA(0, 1), cA + hstep, voffA);
    if (wr == 1) PG8_BAR;
    PG8_WAIT_V(4); PG8_BAR;
    PG8_STAGE(PG8_SB(1, 0), cB + kstep, voffB); PG8_STAGE(PG8_SA(1, 0), cA + kstep, voffA); PG8_STAGE(PG8_SB(1, 1), cB + hstep + kstep, voffB);
    PG8_WAIT_V(6); PG8_BAR;
    PG8_STAMP();
    for (;;) {
        const bool has_next = S.next(ui + 1, nxt);
        const char* nA = has_next ? (const char*)g.A + (size_t)nxt.pm * tstep : cA; const char* nB = has_next ? (const char*)g.Bt + (size_t)nxt.pn * tstep : cB;
        for (int t = 0; t < nt; t += 2) {
            const bool last = (t == nt - 2);
            const char* a1 = cA + (size_t)(t + 1) * kstep;
            const char* a2 = last ? nA : cA + (size_t)(t + 2) * kstep; const char* b2 = last ? nB : cB + (size_t)(t + 2) * kstep;
            const char* a3 = a2 + kstep; const char* b3 = b2 + kstep;
            if (last && has_next) S.a_ready(nxt);
            PG8_LDB(B0, 0, 0); PG8_SCHED; PG8_LDA(At, 0, 0); PG8_STAGE(PG8_SA(1, 1), a1 + hstep, voffA);
            PG8_WAIT_L(8); PG8_BAR; PG8_WAIT_L(0); PG8_MMA(0, 0, At, B0); PG8_BAR; PG8_SCHED;
            PG8_LDB(B1, 0, 1); PG8_STAGE(PG8_SB(0, 0), b2, voffB);
            PG8_BAR; PG8_WAIT_L(0); PG8_MMA(0, 1, At, B1); PG8_BAR;
            PG8_LDA(At, 0, 1); PG8_STAGE(PG8_SA(0, 0), a2, voffA);
            PG8_BAR; PG8_WAIT_L(0); PG8_MMA(1, 0, At, B0); PG8_BAR; PG8_SCHED;
            PG8_STAGE(PG8_SB(0, 1), b2 + hstep, voffB);
            PG8_WAIT_V(6); PG8_BAR; PG8_MMA(1, 1, At, B1); PG8_BAR;
            PG8_LDB(B0, 1, 0); PG8_SCHED; PG8_LDA(At, 1, 0); PG8_STAGE(PG8_SA(0, 1), a2 + hstep, voffA);
            PG8_WAIT_L(8); PG8_BAR; PG8_WAIT_L(0); PG8_MMA(0, 0, At, B0); PG8_BAR; PG8_SCHED;
            PG8_LDB(B1, 1, 1); PG8_STAGE(PG8_SB(1, 0), b3, voffB);
            PG8_BAR; PG8_WAIT_L(0); PG8_MMA(0, 1, At, B1); PG8_BAR;
            PG8_LDA(At, 1, 1); PG8_STAGE(PG8_SA(1, 0), a3, voffA);
            PG8_BAR; PG8_WAIT_L(0); PG8_MMA(1, 0, At, B0); PG8_BAR; PG8_SCHED;
            PG8_STAGE(PG8_SB(1, 1), b3 + hstep, voffB);
            PG8_WAIT_V(6); PG8_BAR; PG8_MMA(1, 1, At, B1); PG8_BAR;
        }
        PG8_STAMP();
        if constexpr (!Epi::AFTER_DRAIN) { E(acc, cur, wr, wc, fr, fq); S.done(cur); }
        PG8_STAMP();
        if (!has_next) break;
#pragma unroll
        for (int a = 0; a < 2; ++a)
#pragma unroll
            for (int b = 0; b < 2; ++b)
#pragma unroll
                for (int m = 0; m < 4; ++m)
#pragma unroll
                    for (int n = 0; n < 2; ++n) acc[a][b][m][n] = (f32x4){0.f, 0.f, 0.f, 0.f};
        cur = nxt; cA = nA; cB = nB; ++ui;
    }
    PG8_WAIT_V(0);
    if (wr == 0) PG8_BAR;
    PG8_BAR;
    if constexpr (Epi::AFTER_DRAIN) { E.fused(acc, cur, wr, wc, fr, fq, lds, wid, lane); S.done(cur); }
    PG8_STAMP();
    if (STAMP && wid == 0) { stamps[lane] = lane < nts ? (((unsigned long long)(unsigned)ts_hi << 32) | (unsigned)ts_lo) : 0ull;
        if (lane == 62) stamps[62] = rt_entry; if (lane == 63) stamps[63] = (unsigned long long)wall_clock64(); }
#undef PG8_STAMP
#undef PG8_SA
#undef PG8_SB
#undef PG8_STAGE
#undef PG8_LDA
#undef PG8_LDB
#undef PG8_MMA
#undef PG8_WAIT_V
#undef PG8_WAIT_L
#undef PG8_BAR
#undef PG8_SCHED
}
}

typedef unsigned short bf16_t;
typedef float f32x4 __attribute__((ext_vector_type(4)));
__device__ __forceinline__ int opaque_tid() { int t = threadIdx.x; asm volatile("" : "+v"(t)); return t; }
typedef unsigned u32x4 __attribute__((ext_vector_type(4)));

__device__ __forceinline__ bf16_t f2bf(float f) { return __builtin_bit_cast(bf16_t, (__bf16)f); }
typedef __bf16 bf16x2n_t __attribute__((ext_vector_type(2)));
typedef float f32x2n_t __attribute__((ext_vector_type(2)));
__device__ __forceinline__ unsigned pack2bf(float lo, float hi) { return __builtin_bit_cast(unsigned, __builtin_convertvector((f32x2n_t){lo, hi}, bf16x2n_t)); }
__device__ __forceinline__ float bf2f(bf16_t b) { return __uint_as_float(((unsigned)b) << 16); }
__device__ __forceinline__ float sigmoidf_(float x) { return __builtin_amdgcn_rcpf(1.f + __expf(-x)); }
__device__ __forceinline__ float gelu_tanh(float x) {
    float u = 0.7978845608028654f * (x + 0.044715f * x * x * x);
    return 0.5f * x * (1.f + tanhf(u));
}
__device__ __forceinline__ float gelu_erf(float x) { return 0.5f * x * (1.f + erff(x * 0.70710678118654752f)); }
__device__ __forceinline__ float gelu_as(float v) {
    const float av = fabsf(v), d = av * 0.2316418882f + 1.0f;
    const float t = __builtin_amdgcn_rcpf(d);
    float q = t * 0.5307027145f + (-0.7265760135f); q = q * t + 0.7107068705f; q = q * t + (-0.142248368f); q = q * t + 0.127414796f; q = q * t;
    const float e = __builtin_amdgcn_exp2f((v * v) * (-0.72134752044f));
    const float m = v * (q * e), r = v - m;
    return v < 0.f ? m : r;
}

struct EpiResF32 {
    static constexpr bool PERM = false, AFTER_DRAIN = false;
    float* C; int ldc; const float* X; float alpha;
    __device__ __forceinline__ void operator()(const pg8::f32x4 (&acc)[2][2][4][2], const pg8::Unit& u, int wr, int wc, int fr, int fq) const {
        const int row0 = u.pm * pg8::BM + wr * 64 + fr, col0 = u.pn * pg8::BM + wc * 32 + 4 * fq;
#pragma unroll
        for (int ai = 0; ai < 2; ++ai)
#pragma unroll
            for (int m = 0; m < 4; ++m) {
                const size_t ro = (size_t)(row0 + ai * pg8::HALF + m * 16) * ldc + col0;
#pragma unroll
                for (int bj = 0; bj < 2; ++bj)
#pragma unroll
                    for (int n = 0; n < 2; ++n) {
                        const pg8::f32x4 xv = *(const pg8::f32x4*)(X + ro + bj * pg8::HALF + n * 16);
                        *(pg8::f32x4*)(C + ro + bj * pg8::HALF + n * 16) = acc[ai][bj][m][n] + xv * alpha;
                    }
            }
    }
};
struct EpiBf16 {
    static constexpr bool PERM = true, AFTER_DRAIN = false;
    bf16_t* O; int ldc;
    __device__ __forceinline__ void operator()(const pg8::f32x4 (&acc)[2][2][4][2], const pg8::Unit& u, int wr, int wc, int fr, int fq) const {
        const int row0 = u.pm * pg8::BM + wr * 64 + fr;
        const int col0 = u.pn * pg8::BM + wc * 32 + 8 * fq;
#pragma unroll
        for (int ai = 0; ai < 2; ++ai)
#pragma unroll
            for (int m = 0; m < 4; ++m) {
                bf16_t* rowp = O + (size_t)(row0 + ai * pg8::HALF + m * 16) * ldc + col0;
#pragma unroll
                for (int bj = 0; bj < 2; ++bj) {
                    const pg8::f32x4 v0 = acc[ai][bj][m][0], v1 = acc[ai][bj][m][1];
                    pg8::u32x4 w; w.x = pg8::cvt_pk_bf16(v0[0], v0[1]); w.y = pg8::cvt_pk_bf16(v0[2], v0[3]); w.z = pg8::cvt_pk_bf16(v1[0], v1[1]); w.w = pg8::cvt_pk_bf16(v1[2], v1[3]);
                    *(pg8::u32x4*)(rowp + bj * pg8::HALF) = w;
                }
            }
    }
};

__device__ __forceinline__ void cvt_unit(size_t unit, const float* __restrict__ src, bf16_t* __restrict__ dst) {
    const size_t o = unit * 4096 + (size_t)threadIdx.x * 8;
    const f32x4 a = *(const f32x4*)(src + o), b = *(const f32x4*)(src + o + 4);
    u32x4 w; w.x = pack2bf(a[0], a[1]); w.y = pack2bf(a[2], a[3]); w.z = pack2bf(b[0], b[1]); w.w = pack2bf(b[2], b[3]);
    *(u32x4*)(dst + o) = w;
}
__device__ __forceinline__ void transpose_unit(int unit, const float* __restrict__ in, bf16_t* __restrict__ out, int R, int C, float* tile  ,
                                               const float* __restrict__ rowscale = nullptr, const float* __restrict__ rowbias = nullptr, float* __restrict__ p1 = nullptr, float* __restrict__ p2 = nullptr) {
    const int ntc = C / 64;
    const int r0 = (unit / ntc) * 64, c0 = (unit % ntc) * 64;
    float* tile2 = tile + 64 * 65;
    __syncthreads();
#pragma unroll
    for (int i = 0; i < 8; i++) {
        int e = threadIdx.x + i * NTHR;
        int r = e >> 6, c = e & 63;
        const float v = in[(size_t)(r0 + r) * C + c0 + c];
        tile[r * 65 + c] = rowscale ? v * rowscale[r0 + r] : v;
        if (rowscale) tile2[r * 65 + c] = v * rowbias[r0 + r];
    }
    __syncthreads();
#pragma unroll
    for (int i = 0; i < 8; i++) {
        int e = threadIdx.x + i * NTHR;
        int c = e >> 6, r = e & 63;
        out[(size_t)(c0 + c) * R + r0 + r] = f2bf(tile[r * 65 + c]);
    }
    if (rowscale && threadIdx.x < 64) {
        float s1 = 0.f, s2 = 0.f;
        for (int r = 0; r < 64; ++r) { s1 += tile[r * 65 + threadIdx.x]; s2 += tile2[r * 65 + threadIdx.x]; }
        p1[(size_t)(r0 / 64) * C + c0 + threadIdx.x] = s1;
        p2[(size_t)(r0 / 64) * C + c0 + threadIdx.x] = s2;
    }
}

typedef __bf16 bf16x2_t __attribute__((ext_vector_type(2)));
__device__ __forceinline__ float dot2bf(unsigned a, unsigned b, float c) { return __builtin_amdgcn_fdot2_f32_bf16(__builtin_bit_cast(bf16x2_t, a), __builtin_bit_cast(bf16x2_t, b), c, false); }
template <int CTRL> __device__ __forceinline__ float dppf(float x) { return __builtin_bit_cast(float, __builtin_amdgcn_mov_dpp(__builtin_bit_cast(int, x), CTRL, 0xf, 0xf, true)); }
#define DPP_XOR1 0xB1
#define DPP_XOR2 0x4E
#define DPP_XOR7 0x141
#define DPP_XOR8 0x128
__device__ __forceinline__ float xrow16_sum(float x) {
    auto s = __builtin_amdgcn_permlane16_swap(__float_as_uint(x), __float_as_uint(x), false, false);
    x = __uint_as_float(s[0]) + __uint_as_float(s[1]);
    auto t = __builtin_amdgcn_permlane32_swap(__float_as_uint(x), __float_as_uint(x), false, false);
    return __uint_as_float(t[0]) + __uint_as_float(t[1]);
}
__device__ __forceinline__ float wave_sum(float x) {
    x += dppf<DPP_XOR1>(x); x += dppf<DPP_XOR2>(x); x += dppf<DPP_XOR7>(x); x += dppf<DPP_XOR8>(x);
    return xrow16_sum(x);
}
__device__ __forceinline__ float tr_reduce16(float (&p)[16], int c) {
#define TR_STEP(HALF, CTRL, BIT) _Pragma("unroll") for (int h = 0; h < (HALF); ++h) { \
        const float lo_ = p[h], hi_ = p[h + (HALF)]; const float t1_ = lo_ + dppf<CTRL>(lo_), t2_ = hi_ + dppf<CTRL>(hi_); \
        p[h] = (c & (BIT)) ? t2_ : t1_; }
    TR_STEP(8, DPP_XOR8, 8) TR_STEP(4, DPP_XOR7, 4) TR_STEP(2, DPP_XOR2, 2) TR_STEP(1, DPP_XOR1, 1)
#undef TR_STEP
    return xrow16_sum(p[0]);
}
#define G_LOAD(R, tab, idreg, k0) do { _Pragma("unroll") for (int j_ = 0; j_ < 8; ++j_) { \
        const int id_ = __builtin_amdgcn_readlane((idreg), (k0) + j_); \
        const u32x4* rp_ = (const u32x4*)((tab) + (size_t)id_ * 1024); \
        R[j_][0] = rp_[lane]; R[j_][1] = rp_[64 + lane]; } } while (0)
#define G_DOT(R, p, o) do { _Pragma("unroll") for (int j_ = 0; j_ < 8; ++j_) { \
        float d0_ = dot2bf(R[j_][0].x, xp[0], 0.f), d1_ = dot2bf(R[j_][0].y, xp[1], 0.f); \
        d0_ = dot2bf(R[j_][0].z, xp[2], d0_); d1_ = dot2bf(R[j_][0].w, xp[3], d1_); \
        d0_ = dot2bf(R[j_][1].x, xp[4], d0_); d1_ = dot2bf(R[j_][1].y, xp[5], d1_); \
        d0_ = dot2bf(R[j_][1].z, xp[6], d0_); d1_ = dot2bf(R[j_][1].w, xp[7], d1_); \
        p[(o) + j_] = d0_ + d1_; } } while (0)
#define G_ACC1(u_, i_, w_) do { y[(i_)] = fmaf((w_), __uint_as_float((u_) << 16), y[(i_)]); y[(i_) + 1] = fmaf((w_), __uint_as_float((u_) & 0xffff0000u), y[(i_) + 1]); } while (0)
#define G_ACC(R, wreg, k0) do { _Pragma("unroll") for (int j_ = 0; j_ < 8; ++j_) { \
        const float w_ = __uint_as_float((unsigned)__builtin_amdgcn_readlane((int)__float_as_uint(wreg), (k0) + j_)); \
        G_ACC1(R[j_][0].x, 0, w_); G_ACC1(R[j_][0].y, 2, w_); G_ACC1(R[j_][0].z, 4, w_); G_ACC1(R[j_][0].w, 6, w_); \
        G_ACC1(R[j_][1].x, 8, w_); G_ACC1(R[j_][1].y, 10, w_); G_ACC1(R[j_][1].z, 12, w_); G_ACC1(R[j_][1].w, 14, w_); } } while (0)

typedef short bf16x8_t __attribute__((ext_vector_type(8)));
typedef float f32x16 __attribute__((ext_vector_type(16)));
#define HG_P272 272
#define HG_P144 144
#define HG_QH   0
#define HG_KH   (HG_QH + 64 * 272)
#define HG_QT   (HG_KH + 64 * 272)
#define HG_VT   (HG_QT + 64 * 272)
#define HG_ST   (HG_VT + 128 * 144)
#define HG_PM   (HG_ST + 128 * 272)
#define HG_SEG  (HG_PM + 64 * 144)
#define HG_RSQ  (HG_SEG + 4096)
#define HG_END  (HG_RSQ + 1024)

__device__ __forceinline__ float hg_lb(const float* __restrict__ lbl, int c) { return 1.f / (1.f + __expf(lbl[512 + c] - lbl[c])); }
__device__ __forceinline__ float sel4(const float (&v)[4], int k) { return k == 0 ? v[0] : k == 1 ? v[1] : k == 2 ? v[2] : v[3]; }
__device__ __forceinline__ float pklo(unsigned w) { return __uint_as_float(w << 16); }
__device__ __forceinline__ float pkhi(unsigned w) { return __uint_as_float(w & 0xffff0000u); }
__device__ __forceinline__ void hg_prep(const unsigned (&fw)[8], float lb0, float lb1, int dp, int ts, float* seg  ,
                                        float (&kk)[16], float (&bb)[16], float (&tot)[2], float (&bref)[2]) {
    float run0 = 1.f, run1 = 1.f;
#pragma unroll
    for (int i = 0; i < 8; ++i) {
        const float s0 = sigmoidf_(pklo(fw[i])), s1 = sigmoidf_(pkhi(fw[i]));
        kk[2 * i] = (1.f - lb0) * (1.f - s0); kk[2 * i + 1] = (1.f - lb1) * (1.f - s1);
        run0 *= lb0 + (1.f - lb0) * s0; run1 *= lb1 + (1.f - lb1) * s1;
        bb[2 * i] = run0; bb[2 * i + 1] = run1;
    }
    *(float2*)(seg + ts * 128 + 2 * dp) = make_float2(run0, run1);
    __syncthreads();
    float pre0 = 1.f, pre1 = 1.f, t0 = 1.f, t1 = 1.f, r0 = 1.f, r1 = 1.f;
#pragma unroll
    for (int s = 0; s < 8; ++s) {
        const float2 v = *(const float2*)(seg + s * 128 + 2 * dp);
        if (s < ts) { pre0 *= v.x; pre1 *= v.y; }
        if (s < 4) { r0 *= v.x; r1 *= v.y; }
        t0 *= v.x; t1 *= v.y;
    }
    tot[0] = t0; tot[1] = t1; bref[0] = r0; bref[1] = r1;
#pragma unroll
    for (int i = 0; i < 8; ++i) { bb[2 * i] *= pre0; bb[2 * i + 1] *= pre1; }
}
__device__ __forceinline__ void hg_store8x2(unsigned char* base, int dp, int ts, const float (&v)[16]) {
    u32x4 w0, w1;
    w0.x = pack2bf(v[0], v[2]); w0.y = pack2bf(v[4], v[6]); w0.z = pack2bf(v[8], v[10]); w0.w = pack2bf(v[12], v[14]);
    w1.x = pack2bf(v[1], v[3]); w1.y = pack2bf(v[5], v[7]); w1.z = pack2bf(v[9], v[11]); w1.w = pack2bf(v[13], v[15]);
    *(u32x4*)(base + (2 * dp) * HG_P144 + ts * 16) = w0;
    *(u32x4*)(base + (2 * dp + 1) * HG_P144 + ts * 16) = w1;
}
__device__ __forceinline__ void hg_store8x2_raw(unsigned char* base, int dp, int ts, const unsigned (&p)[8]) {
    u32x4 w0, w1;
    w0.x = __builtin_amdgcn_perm(p[1], p[0], 0x05040100u); w0.y = __builtin_amdgcn_perm(p[3], p[2], 0x05040100u);
    w0.z = __builtin_amdgcn_perm(p[5], p[4], 0x05040100u); w0.w = __builtin_amdgcn_perm(p[7], p[6], 0x05040100u);
    w1.x = __builtin_amdgcn_perm(p[1], p[0], 0x07060302u); w1.y = __builtin_amdgcn_perm(p[3], p[2], 0x07060302u);
    w1.z = __builtin_amdgcn_perm(p[5], p[4], 0x07060302u); w1.w = __builtin_amdgcn_perm(p[7], p[6], 0x07060302u);
    *(u32x4*)(base + (2 * dp) * HG_P144 + ts * 16) = w0;
    *(u32x4*)(base + (2 * dp + 1) * HG_P144 + ts * 16) = w1;
}
__device__ __forceinline__ void hg_store16(unsigned char* base, int col, int tq, const float (&v)[16]) {
    u32x4 w0, w1;
    w0.x = pack2bf(v[0], v[1]); w0.y = pack2bf(v[2], v[3]); w0.z = pack2bf(v[4], v[5]); w0.w = pack2bf(v[6], v[7]);
    w1.x = pack2bf(v[8], v[9]); w1.y = pack2bf(v[10], v[11]); w1.z = pack2bf(v[12], v[13]); w1.w = pack2bf(v[14], v[15]);
    *(u32x4*)(base + col * HG_P144 + tq * 32) = w0;
    *(u32x4*)(base + col * HG_P144 + tq * 32 + 16) = w1;
}
__device__ __forceinline__ bf16x8_t hg_frag(const unsigned char* base, int pitch, int row, int kelem) {
    return *(const bf16x8_t*)(base + row * pitch + kelem * 2);
}

struct HgP2Regs { unsigned f[8], v[8]; };
__device__ __forceinline__ void hgrn_p2_load(int unit, const bf16_t* __restrict__ h, HgP2Regs& R) {
    const int b = unit >> 9, hh = (unit >> 7) & 3, ch = unit & 127;
    const int tx = opaque_tid();
    const int dp = tx & 63, ts = tx >> 6;
    const size_t t0 = (size_t)b * SEQ + ch * 64 + ts * 8;
#pragma unroll
    for (int i = 0; i < 8; ++i) {
        const unsigned* hr = (const unsigned*)(h + (t0 + i) * INW + hh * 128) + dp;
        R.f[i] = hr[1536 / 2]; R.v[i] = hr[2048 / 2];
    }
}
__device__ __forceinline__ void hgrn_p2_body(int unit, const HgP2Regs& R, const float (&lb4)[2][4], bf16_t* __restrict__ kv, float* __restrict__ gam, unsigned char* lds) {
    const int hh = (unit >> 7) & 3;
    const int tx = opaque_tid();
    const int dp = tx & 63, ts = tx >> 6;
    const int lane = tx & 63, w = tx >> 6;
    __syncthreads();
    float kk[16], bb[16], tot[2], bref[2];
    hg_prep(R.f, sel4(lb4[0], hh), sel4(lb4[1], hh), dp, ts, (float*)(lds + HG_SEG), kk, bb, tot, bref);
    float tmp[16];
#pragma unroll
    for (int i = 0; i < 16; ++i) tmp[i] = kk[i] * tot[i & 1] * __builtin_amdgcn_rcpf(bb[i]);
    hg_store8x2(lds + HG_ST, dp, ts, tmp);
    hg_store8x2_raw(lds + HG_VT, dp, ts, R.v);
    if (ts == 0) *(float2*)(gam + (size_t)unit * 128 + 2 * dp) = make_float2(tot[0], tot[1]);
    __syncthreads();
    const int mt = w >> 1;
    f32x16 acc[2];
#pragma unroll
    for (int n = 0; n < 2; ++n)
#pragma unroll
        for (int r = 0; r < 16; ++r) acc[n][r] = 0.f;
#pragma unroll
    for (int ks = 0; ks < 4; ++ks) {
        const int kel = ks * 16 + 8 * (lane >> 5);
        const bf16x8_t a = hg_frag(lds + HG_VT, HG_P144, mt * 32 + (lane & 31), kel);
#pragma unroll
        for (int n = 0; n < 2; ++n) {
            const int nt = 2 * (w & 1) + n;
            const bf16x8_t bf = hg_frag(lds + HG_ST, HG_P144, nt * 32 + (lane & 31), kel);
            acc[n] = __builtin_amdgcn_mfma_f32_32x32x16_bf16(a, bf, acc[n], 0, 0, 0);
        }
    }
    bf16_t* o = kv + (size_t)unit * 16384;
#pragma unroll
    for (int n = 0; n < 2; ++n) {
        const int nt = 2 * (w & 1) + n;
#pragma unroll
        for (int r = 0; r < 16; ++r) {
            const int e = mt * 32 + (r & 3) + 8 * (r >> 2) + 4 * (lane >> 5);
            o[e * 128 + nt * 32 + (lane & 31)] = f2bf(acc[n][r]);
        }
    }
}

__device__ void hgrn_scan4(int tid256, bf16_t* __restrict__ kv, const float* __restrict__ gam) {
    const int gid = blockIdx.x * 256 + tid256;
    const int bh = gid >> 12, rem = gid & 4095;
    const int d = (rem & 31) * 4;
    uint2* p = (uint2*)(kv + (size_t)bh * 128 * 16384) + rem;
    const float* gp = gam + (size_t)bh * 128 * 128 + d;
    float s0 = 0.f, s1 = 0.f, s2 = 0.f, s3 = 0.f;
    for (int c0 = 0; c0 < 128; c0 += 8) {
        uint2 kvv[8]; f32x4 g[8];
#pragma unroll
        for (int j = 0; j < 8; ++j) { kvv[j] = p[(size_t)(c0 + j) * 4096]; g[j] = *(const f32x4*)(gp + (c0 + j) * 128); }
#pragma unroll
        for (int j = 0; j < 8; ++j) {
            uint2 o; o.x = pack2bf(s0, s1); o.y = pack2bf(s2, s3);
            p[(size_t)(c0 + j) * 4096] = o;
            s0 = fmaf(g[j][0], s0, __uint_as_float(kvv[j].x << 16));
            s1 = fmaf(g[j][1], s1, __uint_as_float(kvv[j].x & 0xffff0000u));
            s2 = fmaf(g[j][2], s2, __uint_as_float(kvv[j].y << 16));
            s3 = fmaf(g[j][3], s3, __uint_as_float(kvv[j].y & 0xffff0000u));
        }
    }
}

struct HgP4Regs { u32x4 stv[4]; unsigned f[8], q[8], v[8]; bf16_t gvr[16]; };
__device__ __forceinline__ void hgrn_p4_load(int unit, const bf16_t* __restrict__ h, const bf16_t* __restrict__ st, HgP4Regs& R) {
    const int b = unit >> 9, hh = (unit >> 7) & 3, ch = unit & 127;
    const int tx = opaque_tid();
    const int dp = tx & 63, ts = tx >> 6;
    const int lane = tx & 63, w = tx >> 6;
    const size_t tb = (size_t)b * SEQ + ch * 64;
    const size_t t0 = tb + ts * 8;
    const int mt = w >> 2, nt = w & 3;
    const u32x4* sp = (const u32x4*)(st + (size_t)unit * 16384);
#pragma unroll
    for (int i = 0; i < 4; ++i) R.stv[i] = sp[tx + i * NTHR];
#pragma unroll
    for (int i = 0; i < 8; ++i) {
        const unsigned* hr = (const unsigned*)(h + (t0 + i) * INW + hh * 128) + dp;
        R.f[i] = hr[1536 / 2]; R.q[i] = hr[1024 / 2]; R.v[i] = hr[2048 / 2];
    }
#pragma unroll
    for (int r = 0; r < 16; ++r) R.gvr[r] = h[(tb + mt * 32 + (r & 3) + 8 * (r >> 2) + 4 * (lane >> 5)) * INW + 2560 + hh * 128 + nt * 32 + (lane & 31)];
}
__device__ __forceinline__ void hgrn_p4_body(int unit, const HgP4Regs& R, const float (&lb4)[2][4], const float (&gn4)[4], bf16_t* __restrict__ mixin, unsigned char* lds) {
    const int b = unit >> 9, hh = (unit >> 7) & 3, ch = unit & 127;
    const int tx = opaque_tid();
    const int dp = tx & 63, ts = tx >> 6;
    const int lane = tx & 63, w = tx >> 6;
    const size_t tb = (size_t)b * SEQ + ch * 64;
    const int mt = w >> 2, nt = w & 3;
    __syncthreads();
    float kk[16], bb[16], tot[2], bref[2];
    hg_prep(R.f, sel4(lb4[0], hh), sel4(lb4[1], hh), dp, ts, (float*)(lds + HG_SEG), kk, bb, tot, bref);
    const float iref0 = __builtin_amdgcn_rcpf(bref[0]), iref1 = __builtin_amdgcn_rcpf(bref[1]);
#pragma unroll
    for (int i = 0; i < 8; ++i) {
        const float q0 = pklo(R.q[i]), q1 = pkhi(R.q[i]);
        const int t = ts * 8 + i;
        const float qt0 = q0 * bb[2 * i], qt1 = q1 * bb[2 * i + 1];
        *(unsigned*)(lds + HG_QH + t * HG_P272 + dp * 4) = pack2bf(qt0 * iref0, qt1 * iref1);
        *(unsigned*)(lds + HG_KH + t * HG_P272 + dp * 4) = pack2bf(kk[2 * i] * bref[0] * __builtin_amdgcn_rcpf(bb[2 * i]), kk[2 * i + 1] * bref[1] * __builtin_amdgcn_rcpf(bb[2 * i + 1]));
        *(unsigned*)(lds + HG_QT + t * HG_P272 + dp * 4) = pack2bf(qt0, qt1);
    }
    hg_store8x2_raw(lds + HG_VT, dp, ts, R.v);
    {
#pragma unroll
        for (int i = 0; i < 4; ++i) {
            const int pc = tx + i * NTHR;
            *(u32x4*)(lds + HG_ST + (pc >> 4) * HG_P272 + (pc & 15) * 16) = R.stv[i];
        }
    }
    __syncthreads();
    f32x16 acc;
#pragma unroll
    for (int r = 0; r < 16; ++r) acc[r] = 0.f;
#pragma unroll
    for (int ks = 0; ks < 8; ++ks) {
        const int kel = ks * 16 + 8 * (lane >> 5);
        const bf16x8_t a = hg_frag(lds + HG_QT, HG_P272, mt * 32 + (lane & 31), kel);
        const bf16x8_t bf = hg_frag(lds + HG_ST, HG_P272, nt * 32 + (lane & 31), kel);
        acc = __builtin_amdgcn_mfma_f32_32x32x16_bf16(a, bf, acc, 0, 0, 0);
    }
    if (w < 4) {
        const int pm = w >> 1, pn = w & 1;
        f32x16 pa;
#pragma unroll
        for (int r = 0; r < 16; ++r) pa[r] = 0.f;
#pragma unroll
        for (int ks = 0; ks < 8; ++ks) {
            const int kel = ks * 16 + 8 * (lane >> 5);
            const bf16x8_t a = hg_frag(lds + HG_QH, HG_P272, pm * 32 + (lane & 31), kel);
            const bf16x8_t bf = hg_frag(lds + HG_KH, HG_P272, pn * 32 + (lane & 31), kel);
            pa = __builtin_amdgcn_mfma_f32_32x32x16_bf16(a, bf, pa, 0, 0, 0);
        }
        const int s = pn * 32 + (lane & 31);
#pragma unroll
        for (int r = 0; r < 16; ++r) {
            const int t = pm * 32 + (r & 3) + 8 * (r >> 2) + 4 * (lane >> 5);
            const float pv = (s <= t) ? pa[r] : 0.f;
            *(bf16_t*)(lds + HG_PM + t * HG_P144 + s * 2) = f2bf(pv);
        }
    }
    __syncthreads();
#pragma unroll
    for (int ks = 0; ks < 4; ++ks) {
        const int kel = ks * 16 + 8 * (lane >> 5);
        const bf16x8_t a = hg_frag(lds + HG_PM, HG_P144, mt * 32 + (lane & 31), kel);
        const bf16x8_t bf = hg_frag(lds + HG_VT, HG_P144, nt * 32 + (lane & 31), kel);
        acc = __builtin_amdgcn_mfma_f32_32x32x16_bf16(a, bf, acc, 0, 0, 0);
    }
    float* rsq = (float*)(lds + HG_RSQ);
#pragma unroll
    for (int r = 0; r < 16; ++r) {
        float v = acc[r] * acc[r];
        v += dppf<DPP_XOR1>(v); v += dppf<DPP_XOR2>(v); v += dppf<DPP_XOR7>(v); v += dppf<DPP_XOR8>(v);
        auto sw = __builtin_amdgcn_permlane16_swap(__float_as_uint(v), __float_as_uint(v), false, false);
        v = __uint_as_float(sw[0]) + __uint_as_float(sw[1]);
        if ((lane & 31) == 0) rsq[(mt * 32 + (r & 3) + 8 * (r >> 2) + 4 * (lane >> 5)) * 4 + nt] = v;
    }
    __syncthreads();
    const int e = nt * 32 + (lane & 31);
    const float gn = sel4(gn4, hh);
#pragma unroll
    for (int r = 0; r < 16; ++r) {
        const int t = mt * 32 + (r & 3) + 8 * (r >> 2) + 4 * (lane >> 5);
        const f32x4 q4 = *(const f32x4*)(rsq + t * 4);
        const float rs = __builtin_amdgcn_rsqf((q4[0] + q4[1] + q4[2] + q4[3]) * (1.f / 128.f) + 1e-5f);
        const float gv = bf2f(R.gvr[r]);
        const float y = acc[r] * rs * gn * (gv * sigmoidf_(gv));
        mixin[(tb + t) * DM + 512 + hh * 128 + e] = f2bf(y);
    }
}


#define HD __device__ __forceinline__
#ifndef HD
#define HD __host__ __device__ __forceinline__
#endif
HD void sort16_desc(float (&v)[16]) {
#pragma unroll
    for (int k = 2; k <= 16; k <<= 1) {
#pragma unroll
        for (int j = k >> 1; j > 0; j >>= 1) {
#pragma unroll
            for (int i = 0; i < 16; ++i) {
                const int l = i ^ j;
                if (l > i) {
                    const bool desc = ((i & k) == 0);
                    const float a = v[i], b = v[l];
                    const float hi = fmaxf(a, b), lo = fminf(a, b);
                    v[i] = desc ? hi : lo; v[l] = desc ? lo : hi;
                }
            }
        }
    }
}
HD void merge_top16(float (&L)[16], const float (&B)[16]) {
#pragma unroll
    for (int i = 0; i < 16; ++i) L[i] = fmaxf(L[i], B[15 - i]);
#pragma unroll
    for (int j = 8; j > 0; j >>= 1) {
#pragma unroll
        for (int i = 0; i < 16; ++i) {
            const int l = i ^ j;
            if (l > i) { const float a = L[i], b = L[l]; L[i] = fmaxf(a, b); L[l] = fminf(a, b); }
        }
    }
}
HD void insert16(float (&L)[16], float x) {
#pragma unroll
    for (int i = 0; i < 16; ++i) { const float hi = fmaxf(L[i], x); x = fminf(L[i], x); L[i] = hi; }
}

#define TK_SK    0
#define TK_LIST  (2 * 128 * 272)
#define TK_END   (TK_LIST + 2 * 128 * 64)
__device__ void topk_phase(const bf16_t* __restrict__ q, const bf16_t* __restrict__ skb, int* __restrict__ idx, float* __restrict__ gate, unsigned char* lds) {
    const int tx = opaque_tid();
    const int lane = tx & 63, w = tx >> 6;
    const int h = blockIdx.x & 7;
    __syncthreads();
    {
        const u32x4* sp = (const u32x4*)(skb + (size_t)h * 2 * 16384);
#pragma unroll
        for (int i = 0; i < 8; ++i) {
            const int pc = tx + i * NTHR;
            *(u32x4*)(lds + TK_SK + (pc >> 11) * (128 * 272) + ((pc >> 4) & 127) * 272 + (pc & 15) * 16) = sp[pc];
        }
    }
    __syncthreads();
    const int p = w & 1, tile = w >> 1;
    for (int tb = blockIdx.x >> 3; tb < T_TOK / 128; tb += (gridDim.x >> 3)) {
        {
            const int t = tb * 128 + tile * 32 + (lane & 31);
            bf16x8_t bq[8];
            const bf16_t* qp = q + (size_t)t * 2048 + h * 256 + p * 128 + 8 * (lane >> 5);
#pragma unroll
            for (int ks = 0; ks < 8; ++ks) bq[ks] = *(const bf16x8_t*)(qp + ks * 16);
            float L[16];
            const unsigned char* skp = lds + TK_SK + p * (128 * 272);
#pragma unroll
            for (int mt = 0; mt < 4; ++mt) {
                f32x16 acc;
#pragma unroll
                for (int r = 0; r < 16; ++r) acc[r] = 0.f;
#pragma unroll
                for (int ks = 0; ks < 8; ++ks) {
                    const bf16x8_t a = hg_frag(skp, 272, mt * 32 + (lane & 31), ks * 16 + 8 * (lane >> 5));
                    acc = __builtin_amdgcn_mfma_f32_32x32x16_bf16(a, bq[ks], acc, 0, 0, 0);
                }
                float v[16];
#pragma unroll
                for (int r = 0; r < 16; ++r) {
                    const unsigned n = (unsigned)(mt * 32 + (r & 3) + 8 * (r >> 2)) + 4u * (unsigned)(lane >> 5);
                    v[r] = __uint_as_float((__float_as_uint(acc[r]) & ~127u) | n);
                }
                sort16_desc(v);
                if (mt == 0) {
#pragma unroll
                    for (int r = 0; r < 16; ++r) L[r] = v[r];
                } else merge_top16(L, v);
            }
            float Bx[16];
#pragma unroll
            for (int k = 0; k < 16; ++k) Bx[k] = __shfl_xor(L[k], 32);
            merge_top16(L, Bx);
            if (lane < 32) {
                f32x4* lp = (f32x4*)(lds + TK_LIST + (p * 128 + tile * 32 + lane) * 64);
                lp[0] = (f32x4){L[0], L[1], L[2], L[3]}; lp[1] = (f32x4){L[4], L[5], L[6], L[7]};
                lp[2] = (f32x4){L[8], L[9], L[10], L[11]}; lp[3] = (f32x4){L[12], L[13], L[14], L[15]};
            }
        }
        __syncthreads();
        if (tx < 128) {
            const float* l0 = (const float*)(lds + TK_LIST) + tx * 16;
            const float* l1 = (const float*)(lds + TK_LIST) + (128 + tx) * 16;
            float s0[16], s1[16];
#pragma unroll
            for (int k = 0; k < 4; ++k) {
                const f32x4 a = *(const f32x4*)(l0 + 4 * k), b2 = *(const f32x4*)(l1 + 4 * k);
                s0[4 * k] = a[0]; s0[4 * k + 1] = a[1]; s0[4 * k + 2] = a[2]; s0[4 * k + 3] = a[3];
                s1[4 * k] = b2[0]; s1[4 * k + 1] = b2[1]; s1[4 * k + 2] = b2[2]; s1[4 * k + 3] = b2[3];
            }
            float C0[16], C1[16], C2[16], c48 = 0.f, c49 = 0.f;
            int cnt = 0;
#pragma unroll
            for (int i = 0; i < 16; ++i) {
#pragma unroll
                for (int j = 0; j < 16; ++j) {
                    if ((i + 1) * (j + 1) <= 16) {
                        const float cv = __uint_as_float((__float_as_uint(s0[i] + s1[j]) & ~255u) | (unsigned)(i * 16 + j));
                        if (cnt < 16) C0[cnt & 15] = cv; else if (cnt < 32) C1[cnt & 15] = cv; else if (cnt < 48) C2[cnt & 15] = cv; else if (cnt == 48) c48 = cv; else c49 = cv;
                        ++cnt;
                    }
                }
            }
            sort16_desc(C0); sort16_desc(C1); sort16_desc(C2);
            merge_top16(C0, C1); merge_top16(C0, C2);
            insert16(C0, c48); insert16(C0, c49);
            const float mx = __uint_as_float(__float_as_uint(C0[0]) & ~255u);
            float e[16]; float sum = 0.f;
#pragma unroll
            for (int k = 0; k < 16; ++k) { e[k] = __expf(__uint_as_float(__float_as_uint(C0[k]) & ~255u) - mx); sum += e[k]; }
            const float inv = 1.f / sum;
            int id[16];
#pragma unroll
            for (int k = 0; k < 16; ++k) {
                const unsigned pos = __float_as_uint(C0[k]) & 255u;
                const unsigned k0 = __float_as_uint(l0[pos >> 4]) & 127u, k1 = __float_as_uint(l1[pos & 15]) & 127u;
                id[k] = (int)(k0 * 128u + k1);
                e[k] *= inv;
            }
            const size_t o = ((size_t)(tb * 128 + tx) * 8 + h) * 16;
#pragma unroll
            for (int k = 0; k < 4; ++k) {
                *(u32x4*)(idx + o + 4 * k) = (u32x4){(unsigned)id[4 * k], (unsigned)id[4 * k + 1], (unsigned)id[4 * k + 2], (unsigned)id[4 * k + 3]};
                *(f32x4*)(gate + o + 4 * k) = (f32x4){e[4 * k], e[4 * k + 1], e[4 * k + 2], e[4 * k + 3]};
            }
        }
        __syncthreads();
    }
}


typedef float f32x2_t __attribute__((ext_vector_type(2)));
__device__ __forceinline__ unsigned pack_i8x4(float a, float b, float c, float d) {
    const int ia = (int)__builtin_rintf(a), ib = (int)__builtin_rintf(b), ic = (int)__builtin_rintf(c), id = (int)__builtin_rintf(d);
    return ((unsigned)ia & 0xffu) | (((unsigned)ib & 0xffu) << 8) | (((unsigned)ic & 0xffu) << 16) | ((unsigned)id << 24);
}

__device__ __forceinline__ void quant_row(const float* __restrict__ src, unsigned char* __restrict__ dst, float* __restrict__ inv, int row, int lane,
                                          const float* __restrict__ gcol = nullptr, const float* __restrict__ bcol = nullptr, float* __restrict__ cu1 = nullptr, float* __restrict__ cu2 = nullptr, bool as_int8 = false) {
    const float* rp = src + (size_t)row * 1024 + 16 * lane;
    f32x4 a[4];
#pragma unroll
    for (int i = 0; i < 4; ++i) a[i] = *(const f32x4*)(rp + 4 * i);
    if (gcol) {
        float t1 = 0.f, t2 = 0.f;
#pragma unroll
        for (int i = 0; i < 4; ++i) {
            const f32x4 gv = *(const f32x4*)(gcol + 16 * lane + 4 * i), bv = *(const f32x4*)(bcol + 16 * lane + 4 * i);
#pragma unroll
            for (int k = 0; k < 4; ++k) { t2 += a[i][k] * bv[k]; a[i][k] *= gv[k]; t1 += a[i][k]; }
        }
        t1 = wave_sum(t1); t2 = wave_sum(t2);
        if (lane == 0) { cu1[row] = t1; cu2[row] = t2; }
    }
    float m = 0.f;
#pragma unroll
    for (int i = 0; i < 4; ++i) m = fmaxf(fmaxf(fmaxf(fabsf(a[i][0]), fabsf(a[i][1])), fmaxf(fabsf(a[i][2]), fabsf(a[i][3]))), m);
#pragma unroll
    for (int o = 32; o > 0; o >>= 1) m = fmaxf(m, __shfl_xor(m, o));
    const float qmax = as_int8 ? 127.f : 440.f;
    const float sc = m > 0.f ? qmax / m : 1.f;
    u32x4 w;
#pragma unroll
    for (int i = 0; i < 4; ++i) {
        if (as_int8) w[i] = pack_i8x4(a[i][0] * sc, a[i][1] * sc, a[i][2] * sc, a[i][3] * sc);
        else {
            int v = 0;
            v = __builtin_amdgcn_cvt_pk_fp8_f32(a[i][0] * sc, a[i][1] * sc, v, false);
            v = __builtin_amdgcn_cvt_pk_fp8_f32(a[i][2] * sc, a[i][3] * sc, v, true);
            w[i] = (unsigned)v;
        }
    }
#if PEER_SLICED
    *(u32x4*)(dst + (size_t)(lane >> 3) * (16384 * 128) + (size_t)row * 128 + (lane & 7) * 16) = w;
#else
    *(u32x4*)(dst + (size_t)row * 1024 + 16 * lane) = w;
#endif
    if (lane == 0) inv[row] = m > 0.f ? m / qmax : 1.f;
}
#define G8_LOAD(R, tab, idreg, k0) do { _Pragma("unroll") for (int j_ = 0; j_ < 16; ++j_) { \
        const int id_ = __builtin_amdgcn_readlane((idreg), (k0) + j_); \
        R[j_] = ((const u32x4*)((tab) + (size_t)id_ * 1024))[lane]; } } while (0)
#define G8_CVT(u_, f_) do { const f32x2_t lo_ = __builtin_amdgcn_cvt_pk_f32_fp8((int)(u_), false), hi_ = __builtin_amdgcn_cvt_pk_f32_fp8((int)(u_), true); \
        f_[0] = lo_.x; f_[1] = lo_.y; f_[2] = hi_.x; f_[3] = hi_.y; } while (0)
#define G8_DOT(R, p) do { _Pragma("unroll") for (int j_ = 0; j_ < 16; ++j_) { float f_[4]; float d0_, d1_; \
        G8_CVT(R[j_].x, f_); d0_ = f_[0] * xv[0]; d1_ = f_[1] * xv[1]; d0_ = fmaf(f_[2], xv[2], d0_); d1_ = fmaf(f_[3], xv[3], d1_); \
        G8_CVT(R[j_].y, f_); d0_ = fmaf(f_[0], xv[4], d0_); d1_ = fmaf(f_[1], xv[5], d1_); d0_ = fmaf(f_[2], xv[6], d0_); d1_ = fmaf(f_[3], xv[7], d1_); \
        G8_CVT(R[j_].z, f_); d0_ = fmaf(f_[0], xv[8], d0_); d1_ = fmaf(f_[1], xv[9], d1_); d0_ = fmaf(f_[2], xv[10], d0_); d1_ = fmaf(f_[3], xv[11], d1_); \
        G8_CVT(R[j_].w, f_); d0_ = fmaf(f_[0], xv[12], d0_); d1_ = fmaf(f_[1], xv[13], d1_); d0_ = fmaf(f_[2], xv[14], d0_); d1_ = fmaf(f_[3], xv[15], d1_); \
        p[j_] = d0_ + d1_; } } while (0)
#define G8_ACC(R, wreg, k0) do { _Pragma("unroll") for (int j_ = 0; j_ < 16; ++j_) { float f_[4]; \
        const float w_ = __uint_as_float((unsigned)__builtin_amdgcn_readlane((int)__float_as_uint(wreg), (k0) + j_)); \
        G8_CVT(R[j_].x, f_); y[0] = fmaf(w_, f_[0], y[0]); y[1] = fmaf(w_, f_[1], y[1]); y[2] = fmaf(w_, f_[2], y[2]); y[3] = fmaf(w_, f_[3], y[3]); \
        G8_CVT(R[j_].y, f_); y[4] = fmaf(w_, f_[0], y[4]); y[5] = fmaf(w_, f_[1], y[5]); y[6] = fmaf(w_, f_[2], y[6]); y[7] = fmaf(w_, f_[3], y[7]); \
        G8_CVT(R[j_].z, f_); y[8] = fmaf(w_, f_[0], y[8]); y[9] = fmaf(w_, f_[1], y[9]); y[10] = fmaf(w_, f_[2], y[10]); y[11] = fmaf(w_, f_[3], y[11]); \
        G8_CVT(R[j_].w, f_); y[12] = fmaf(w_, f_[0], y[12]); y[13] = fmaf(w_, f_[1], y[13]); y[14] = fmaf(w_, f_[2], y[14]); y[15] = fmaf(w_, f_[3], y[15]); } } while (0)

#define LR_XC    0
#define LR_PV    (32 * 1040)
#define LR_PS    (LR_PV + 32 * 512 * 4)
#define LR_END   (LR_PS + 1024)
#ifndef PF_LRU_F
#define PF_LRU_F 1
#endif
#ifndef PF_LRU_T
#define PF_LRU_T 1
#endif
#ifndef PF_HG2
#define PF_HG2 1
#endif
#ifndef PF_HG4
#define PF_HG4 1
#endif
struct LruConst { float cw0, cw1, cw2, cw3, cbv, bav, bxv, sp8, gv; };
__device__ __forceinline__ void lru2_const(LruConst& K, const float* __restrict__ cw, const float* __restrict__ cb, const float* __restrict__ ba, const float* __restrict__ bx,
                                           const float* __restrict__ lam, const float* __restrict__ ng) {
    const int c = opaque_tid();
    K.cw0 = cw[c]; K.cw1 = cw[512 + c]; K.cw2 = cw[1024 + c]; K.cw3 = cw[1536 + c]; K.cbv = cb[c];
    K.bav = -1.4426950408889634f * ba[c]; K.bxv = -1.4426950408889634f * bx[c]; K.sp8 = -8.f * 1.4426950408889634f * log1pf(expf(-lam[c])); K.gv = ng[c];
}
template <bool FINAL> struct LruRegs { bf16_t xr[35]; bf16_t gr[FINAL ? 32 : 1]; float H; };
template <bool FINAL>
__device__ __forceinline__ void lru2_load(int unit, const bf16_t* __restrict__ h, const float* __restrict__ hseg, LruRegs<FINAL>& R) {
    const int b = unit >> 8, sg = unit & 255;
    const int c = opaque_tid();
    const size_t t0 = (size_t)b * SEQ + sg * 32;
#pragma unroll
    for (int k = 0; k < 35; ++k) R.xr[k] = (sg > 0 || k >= 3) ? h[(t0 + k - 3) * INW + c] : (bf16_t)0;
    if (FINAL) {
#pragma unroll
        for (int t = 0; t < 32; ++t) R.gr[t] = h[(t0 + t) * INW + 512 + c];
        R.H = hseg[(size_t)unit * 512 + c];
    } else {
        R.H = 0.f;
    }
}
__device__ __forceinline__ void lru2_front(const bf16_t (&xr)[35], const LruConst& K, const bf16_t* __restrict__ wT  , unsigned char* lds) {
    const int c = opaque_tid(), hh = c >> 6, lane = c & 63;
    __syncthreads();
#pragma unroll
    for (int t = 0; t < 32; ++t) {
        const float xc = K.cbv + K.cw0 * bf2f(xr[t]) + K.cw1 * bf2f(xr[t + 1]) + K.cw2 * bf2f(xr[t + 2]) + K.cw3 * bf2f(xr[t + 3]);
        *(bf16_t*)(lds + LR_XC + t * 1040 + c * 2) = f2bf(xc);
    }
    {
        f32x16 acc[2][2];
#pragma unroll
        for (int g = 0; g < 2; ++g)
#pragma unroll
            for (int nt = 0; nt < 2; ++nt)
#pragma unroll
                for (int r = 0; r < 16; ++r) acc[g][nt][r] = 0.f;
#pragma unroll
        for (int ks = 0; ks < 4; ++ks) {
            const bf16x8_t a = *(const bf16x8_t*)(lds + LR_XC + (lane & 31) * 1040 + (hh * 64 + ks * 16 + 8 * (lane >> 5)) * 2);
#pragma unroll
            for (int g = 0; g < 2; ++g)
#pragma unroll
                for (int nt = 0; nt < 2; ++nt) {
                    const bf16x8_t bw = *(const bf16x8_t*)(wT + ((size_t)(g * 8 + hh) * 64 + nt * 32 + (lane & 31)) * 64 + ks * 16 + 8 * (lane >> 5));
                    acc[g][nt] = __builtin_amdgcn_mfma_f32_32x32x16_bf16(a, bw, acc[g][nt], 0, 0, 0);
                }
        }
#pragma unroll
        for (int nt = 0; nt < 2; ++nt)
#pragma unroll
            for (int r = 0; r < 16; ++r) {
                const int t = (r & 3) + 8 * (r >> 2) + 4 * (lane >> 5);
                *(unsigned*)(lds + LR_PV + (t * 512 + hh * 64 + nt * 32 + (lane & 31)) * 4) = pack2bf(acc[0][nt][r], acc[1][nt][r]);
            }
    }
}
template <bool FINAL>
__device__ __forceinline__ void lru2_back(int unit, const LruRegs<FINAL>& R, const LruConst& K, float* __restrict__ aseg, float* __restrict__ hseg, bf16_t* __restrict__ mixin, unsigned char* lds) {
    const int b = unit >> 8, sg = unit & 255;
    const int c = opaque_tid(), hh = c >> 6, lane = c & 63;
    const size_t t0 = (size_t)b * SEQ + sg * 32;
    float H = R.H;
    float A = 1.f;
    float vv[FINAL ? 32 : 1];
    float* ps = (float*)(lds + LR_PS);
#pragma unroll
    for (int tb = 0; tb < 32; tb += 16) {
        float sq[16];
#pragma unroll
        for (int k = 0; k < 16; ++k) {
            const int t = tb + k;
            const unsigned pre = *(const unsigned*)(lds + LR_PV + (t * 512 + c) * 4);
            const float xc = bf2f(*(const bf16_t*)(lds + LR_XC + t * 1040 + c * 2));
            const float r = __builtin_amdgcn_rcpf(1.f + __builtin_amdgcn_exp2f(__uint_as_float(pre << 16) + K.bav)), ig = __builtin_amdgcn_rcpf(1.f + __builtin_amdgcn_exp2f(__uint_as_float(pre & 0xffff0000u) + K.bxv));
            const float a = __builtin_amdgcn_exp2f(K.sp8 * r);
            const float u = __builtin_amdgcn_sqrtf(__builtin_amdgcn_fmed3f(1.f - a * a, 0.f, 1.f)) * (ig * xc);
            H = fmaf(a, H, u);
            if (FINAL) {
                const float gt = bf2f(R.gr[t]);
                const float v = H * gt * __builtin_amdgcn_rcpf(1.f + __builtin_amdgcn_exp2f(gt * fmaf(gt * gt, -0.10294324f, -2.3022082f)));
                vv[t] = v;
                sq[k] = v * v;
            } else {
                A *= a;
            }
        }
        if (FINAL) {
            const float tot = tr_reduce16(sq, lane & 15);
            if (lane < 16) ps[(tb + lane) * 8 + hh] = tot;
        }
    }
    if (FINAL) {
        __syncthreads();
        float rsl;
        {
            const f32x4 p0 = *(const f32x4*)(ps + (lane & 31) * 8), p1 = *(const f32x4*)(ps + (lane & 31) * 8 + 4);
            const float tot = (p0[0] + p0[1]) + (p0[2] + p0[3]) + (p1[0] + p1[1]) + (p1[2] + p1[3]);
            rsl = __builtin_amdgcn_rsqf(tot * (1.f / 512.f) + 1e-5f);
        }
#pragma unroll
        for (int t = 0; t < 32; ++t) {
            const float rs = __int_as_float(__builtin_amdgcn_readlane(__float_as_int(rsl), t));
            mixin[(t0 + t) * DM + c] = f2bf(vv[t] * K.gv * rs);
        }
    } else {
        aseg[(size_t)unit * 512 + c] = A;
        hseg[(size_t)unit * 512 + c] = H;
    }
}
template <bool FINAL>
__device__ __forceinline__ void lru2_units(int bid, int G, const bf16_t* __restrict__ h, const float* __restrict__ cw, const float* __restrict__ cb, const bf16_t* __restrict__ wT,
                                           const float* __restrict__ ba, const float* __restrict__ bx, const float* __restrict__ lam, const float* __restrict__ ng,
                                           float* __restrict__ aseg, float* __restrict__ hseg, bf16_t* __restrict__ mixin, unsigned char* lds) {
    if (bid >= 1024) return;
    LruConst K; lru2_const(K, cw, cb, ba, bx, lam, ng);
    LruRegs<FINAL> cur, nxt;
    lru2_load<FINAL>(bid, h, hseg, cur);
#pragma unroll 1
    for (int u = bid; u < 1024; u += G) {
        if (!(FINAL ? PF_LRU_T : PF_LRU_F) && u != bid) lru2_load<FINAL>(u, h, hseg, cur);
        lru2_front(cur.xr, K, wT, lds);
        if ((FINAL ? PF_LRU_T : PF_LRU_F) && u + G < 1024) lru2_load<FINAL>(u + G, h, hseg, nxt);
        lru2_back<FINAL>(u, cur, K, aseg, hseg, mixin, lds);
        if (FINAL ? PF_LRU_T : PF_LRU_F) cur = nxt;
    }
}
__device__ void lru2_carry(int vb, int tid, const float* __restrict__ aseg, float* __restrict__ hseg) {
    const int i = vb * 256 + tid;
    const int b = i >> 9, c = i & 511;
    float Hc = 0.f;
    for (int s0 = 0; s0 < 256; s0 += 8) {
        float av[8], hv[8];
#pragma unroll
        for (int k = 0; k < 8; ++k) { const size_t o = ((size_t)(b * 256 + s0 + k)) * 512 + c; av[k] = aseg[o]; hv[k] = hseg[o]; }
#pragma unroll
        for (int k = 0; k < 8; ++k) { const size_t o = ((size_t)(b * 256 + s0 + k)) * 512 + c; hseg[o] = Hc; Hc = fmaf(av[k], Hc, hv[k]); }
    }
}

struct EpiZ {
    static constexpr bool PERM = false, AFTER_DRAIN = false;
    bf16_t* Zb; const float* X; float* pstat; float alpha;
    __device__ __forceinline__ void operator()(const pg8::f32x4 (&acc)[2][2][4][2], const pg8::Unit& u, int wr, int wc, int fr, int fq) const {
        const int row0 = u.pm * pg8::BM + wr * 64 + fr, col0 = u.pn * pg8::BM + wc * 32 + 4 * fq;
#pragma unroll
        for (int ai = 0; ai < 2; ++ai)
#pragma unroll
            for (int m = 0; m < 4; ++m) {
                const int row = row0 + ai * pg8::HALF + m * 16;
                const size_t ro = (size_t)row * DM + col0;
                float s1 = 0.f, s2 = 0.f;
#pragma unroll
                for (int bj = 0; bj < 2; ++bj)
#pragma unroll
                    for (int n = 0; n < 2; ++n) {
                        const pg8::f32x4 xv = *(const pg8::f32x4*)(X + ro + bj * pg8::HALF + n * 16);
                        const pg8::f32x4 v = acc[ai][bj][m][n] + xv * alpha;
                        uint2 pk; pk.x = pack2bf(v[0], v[1]); pk.y = pack2bf(v[2], v[3]);
                        *(uint2*)(Zb + ro + bj * pg8::HALF + n * 16) = pk;
                        s1 += (v[0] + v[1]) + (v[2] + v[3]);
                        s2 += (v[0] * v[0] + v[1] * v[1]) + (v[2] * v[2] + v[3] * v[3]);
                    }
                s1 = xrow16_sum(s1); s2 = xrow16_sum(s2);
                if (fq == 0) { float2 st; st.x = s1; st.y = s2; *(float2*)(pstat + ((size_t)row * 16 + u.pn * 4 + wc) * 2) = st; }
            }
    }
};
struct EpiQ {
    static constexpr bool PERM = true, AFTER_DRAIN = false;
    bf16_t* O; int ldc; const float* stats; const float* c1; const float* c2;
    __device__ __forceinline__ void operator()(const pg8::f32x4 (&acc)[2][2][4][2], const pg8::Unit& u, int wr, int wc, int fr, int fq) const {
        const int row0 = u.pm * pg8::BM + wr * 64 + fr;
        const int col0 = u.pn * pg8::BM + wc * 32 + 8 * fq;
        pg8::f32x4 k1[2][2], k2[2][2];
#pragma unroll
        for (int bj = 0; bj < 2; ++bj)
#pragma unroll
            for (int n = 0; n < 2; ++n) { k1[bj][n] = *(const pg8::f32x4*)(c1 + col0 + bj * pg8::HALF + 4 * n); k2[bj][n] = *(const pg8::f32x4*)(c2 + col0 + bj * pg8::HALF + 4 * n); }
#pragma unroll
        for (int ai = 0; ai < 2; ++ai)
#pragma unroll
            for (int m = 0; m < 4; ++m) {
                const int row = row0 + ai * pg8::HALF + m * 16;
                const float2 st = *(const float2*)(stats + (size_t)row * 2);
                bf16_t* rowp = O + (size_t)row * ldc + col0;
#pragma unroll
                for (int bj = 0; bj < 2; ++bj) {
                    const pg8::f32x4 v0 = (acc[ai][bj][m][0] - k1[bj][0] * st.x) * st.y + k2[bj][0];
                    const pg8::f32x4 v1 = (acc[ai][bj][m][1] - k1[bj][1] * st.x) * st.y + k2[bj][1];
                    pg8::u32x4 w; w.x = pg8::cvt_pk_bf16(v0[0], v0[1]); w.y = pg8::cvt_pk_bf16(v0[2], v0[3]); w.z = pg8::cvt_pk_bf16(v1[0], v1[1]); w.w = pg8::cvt_pk_bf16(v1[2], v1[3]);
                    *(pg8::u32x4*)(rowp + bj * pg8::HALF) = w;
                }
            }
    }
};

#define XB_TMO      128
#define XB_XCNT(j)  (256  + 64 * (j))
#define XB_XSUB(j)  (1280 + 64 * (j))
#define XB_XGEN(j)  (2304 + 64 * (j))
#define XB_TOP      3328
#define XB_TOPGEN   3392
#define XCD_BAR_WORDS 3456
#define XB_SPIN_CAP (1u << 18)

__device__ __forceinline__ unsigned xb_ld(unsigned* p)              { return __hip_atomic_load(p, __ATOMIC_RELAXED, __HIP_MEMORY_SCOPE_AGENT); }
__device__ __forceinline__ unsigned xb_add(unsigned* p, unsigned v) { return __hip_atomic_fetch_add(p, v, __ATOMIC_RELAXED, __HIP_MEMORY_SCOPE_AGENT); }
__device__ __forceinline__ unsigned xb_xcc_id() { return (unsigned)__builtin_amdgcn_s_getreg((3 << 11) | 20) & 0xFu; }
#define XB_SPIN(cond, bar) do { unsigned _sp = 0; while (cond) { __builtin_amdgcn_s_sleep(1); \
    if ((++_sp & 255u) == 0u) { if (xb_ld(&(bar)[XB_TMO])) break; if (_sp > XB_SPIN_CAP) { atomicAdd(&(bar)[XB_TMO], 1u); break; } } } } while (0)

struct XcdBarrier {
    unsigned* bar; unsigned x;
    volatile LAS unsigned* st;
};

__device__ __forceinline__ XcdBarrier xcd_barrier_post(unsigned* bar, volatile LAS unsigned* st) {
    XcdBarrier b; b.bar = bar; b.x = xb_xcc_id(); b.st = st;
    if (threadIdx.x == 0) (void)xb_add(&bar[XB_XCNT(b.x)], 1u);
    return b;
}
__device__ __forceinline__ void xcd_barrier_complete(unsigned* bar, unsigned x, unsigned& nloc, unsigned& nx) {
    const unsigned G = gridDim.x * gridDim.y * gridDim.z;
    unsigned sum, cnt, mine, sp = 0u;
    for (;;) {
        sum = 0u; cnt = 0u; mine = 0u;
#pragma unroll
        for (unsigned j = 0; j < 16; ++j) { const unsigned c = xb_ld(&bar[XB_XCNT(j)]); sum += c; cnt += (c > 0u) ? 1u : 0u; mine = (j == x) ? c : mine; }
        if (sum == G) break;
        __builtin_amdgcn_s_sleep(1);
        if ((++sp & 255u) == 0u) { if (xb_ld(&bar[XB_TMO])) break; if (sp > XB_SPIN_CAP) { atomicAdd(&bar[XB_TMO], 1u); break; } }
    }
    nloc = mine > 0u ? mine : 1u; nx = cnt > 0u ? cnt : 1u;
}

__device__ __forceinline__ void xcd_barrier(const XcdBarrier& b) {
    asm volatile("s_waitcnt vmcnt(0)" ::: "memory");
    __syncthreads();
    if (threadIdx.x == 0) {
        unsigned* bar = b.bar;
        __builtin_amdgcn_s_waitcnt(0);
        unsigned nloc = b.st[0], nx = b.st[1];
        if (nloc == 0u) { xcd_barrier_complete(bar, b.x, nloc, nx); b.st[0] = nloc; b.st[1] = nx; }
        const unsigned old = xb_add(&bar[XB_XSUB(b.x)], 1u);
        const unsigned gen = old / nloc;
        if (old + 1u == (gen + 1u) * nloc) {
            __builtin_amdgcn_fence(__ATOMIC_RELEASE, "agent");
            asm volatile("s_waitcnt vmcnt(0)" ::: "memory");
            const unsigned og = xb_add(&bar[XB_TOP], 1u);
            const unsigned tg = og / nx;
            if (og + 1u == (tg + 1u) * nx) xb_add(&bar[XB_TOPGEN], 1u);
            else XB_SPIN(xb_ld(&bar[XB_TOPGEN]) == tg, bar);
            __builtin_amdgcn_fence(__ATOMIC_ACQUIRE, "agent");
            xb_add(&bar[XB_XGEN(b.x)], 1u);
            asm volatile("s_waitcnt vmcnt(0)" ::: "memory");
        } else {
            XB_SPIN(xb_ld(&bar[XB_XGEN(b.x)]) == gen, bar);
            __builtin_amdgcn_fence(__ATOMIC_ACQUIRE, "agent");
            asm volatile("s_waitcnt vmcnt(0)" ::: "memory");
        }
    }
    __syncthreads();
}


#define SL_TOKB 512
#define SL_NITEM (T_TOK / SL_TOKB)
__device__ __forceinline__ bool sl_next(unsigned* qw, int& s, int& tried, int& tb, volatile LAS unsigned* bc) {
    for (;;) {
        if (tried >= 8) return false;
        __syncthreads();
        if (threadIdx.x == 0) bc[0] = __hip_atomic_fetch_add(&qw[s], 1u, __ATOMIC_RELAXED, __HIP_MEMORY_SCOPE_AGENT);
        __syncthreads();
        const unsigned v = bc[0];
        if (v < (unsigned)SL_NITEM) { tb = (int)v; return true; }
        s = (s + 1) & 7; ++tried;
    }
}
template <int CTRL> __device__ __forceinline__ int dppi(int x) { return __builtin_amdgcn_mov_dpp(x, CTRL, 0xf, 0xf, true); }
#define SL_ISSUE(R, IA, IB) do { _Pragma("unroll") for (int i_ = 0; i_ < 16; ++i_) { \
        const int id_ = __shfl((i_ < 8) ? (IA) : (IB), (lane & ~7) | (i_ & 7)); \
        R[i_] = *(const u32x4*)(tabs + ((unsigned)id_ * 128u + coff)); } } while (0)
#define SL_META(T_, IA, IB, WA, WB, XV) do { const size_t o_ = (size_t)(T_) * 128 + 16 * g + ci; IA = idx[o_]; IB = idx[o_ + 8]; \
        if (IS_V) { WA = aux[o_]; WB = aux[o_ + 8]; } \
        else { XV[0] = __builtin_bit_cast(f32x4, *(const u32x4*)((const unsigned char*)zbf + (size_t)(T_) * DM + s * 128 + ci * 16)); } } while (0)
template <bool IS_V>
__device__ __forceinline__ void sl_compute(const u32x4 (&R)[16], int t, int s, int lane, int g, int ci, float wa, float wb, const f32x4 (&xq)[4], float* __restrict__ outp) {
    if (!IS_V) {
        const int zq0 = (int)__float_as_uint(xq[0][0]), zq1 = (int)__float_as_uint(xq[0][1]), zq2 = (int)__float_as_uint(xq[0][2]), zq3 = (int)__float_as_uint(xq[0][3]);
        float pr[16];
#pragma unroll
        for (int i = 0; i < 16; ++i) {
            int acc = __builtin_amdgcn_sdot4((int)R[i].x, zq0, 0, false);
            acc = __builtin_amdgcn_sdot4((int)R[i].y, zq1, acc, false);
            acc = __builtin_amdgcn_sdot4((int)R[i].z, zq2, acc, false);
            acc = __builtin_amdgcn_sdot4((int)R[i].w, zq3, acc, false);
            pr[i] = (float)acc;
        }
#define DPP_ADD(dst, x, CTRLSTR) asm volatile("s_nop 1\n\tv_add_f32_dpp %0, %1, %1 " CTRLSTR " row_mask:0xf bank_mask:0xf bound_ctrl:1" : "=&v"(dst) : "v"(x))
#define TR8_STEP(HALF, CTRLSTR, BIT) _Pragma("unroll") for (int h_ = 0; h_ < (HALF); ++h_) { \
            const float lo_ = pr[h_], hi_ = pr[h_ + (HALF)]; float t1_, t2_; DPP_ADD(t1_, lo_, CTRLSTR); DPP_ADD(t2_, hi_, CTRLSTR); \
            pr[h_] = (ci & (BIT)) ? t2_ : t1_; }
        TR8_STEP(8, "row_half_mirror", 4) TR8_STEP(4, "quad_perm:[2,3,0,1]", 2) TR8_STEP(2, "quad_perm:[1,0,3,2]", 1)
#undef TR8_STEP
#undef DPP_ADD
        *(unsigned*)((bf16_t*)outp + ((size_t)s * T_TOK + t) * 128 + 16 * g + 8 * ((ci >> 2) & 1) + 4 * ((ci >> 1) & 1) + 2 * (ci & 1)) = pack2bf(pr[0], pr[1]);
    } else {
        f32x2_t y2[8];
#pragma unroll
        for (int i = 0; i < 8; ++i) y2[i] = (f32x2_t){0.f, 0.f};
#pragma unroll
        for (int i = 0; i < 16; ++i) {
            const float w_ = __shfl((i < 8) ? wa : wb, (lane & ~7) | (i & 7));
            const f32x2_t w2 = {w_, w_};
            y2[0] = __builtin_amdgcn_cvt_pk_f32_fp8((int)R[i].x, false) * w2 + y2[0];
            y2[1] = __builtin_amdgcn_cvt_pk_f32_fp8((int)R[i].x, true) * w2 + y2[1];
            y2[2] = __builtin_amdgcn_cvt_pk_f32_fp8((int)R[i].y, false) * w2 + y2[2];
            y2[3] = __builtin_amdgcn_cvt_pk_f32_fp8((int)R[i].y, true) * w2 + y2[3];
            y2[4] = __builtin_amdgcn_cvt_pk_f32_fp8((int)R[i].z, false) * w2 + y2[4];
            y2[5] = __builtin_amdgcn_cvt_pk_f32_fp8((int)R[i].z, true) * w2 + y2[5];
            y2[6] = __builtin_amdgcn_cvt_pk_f32_fp8((int)R[i].w, false) * w2 + y2[6];
            y2[7] = __builtin_amdgcn_cvt_pk_f32_fp8((int)R[i].w, true) * w2 + y2[7];
        }
        float y[16];
#pragma unroll
        for (int i = 0; i < 8; ++i) { y[2 * i] = y2[i].x; y[2 * i + 1] = y2[i].y; }
#pragma unroll
        for (int h = 0; h < 8; ++h) {
            const float lo_ = y[h], hi_ = y[h + 8]; const float t1_ = lo_ + dppf<DPP_XOR8>(lo_), t2_ = hi_ + dppf<DPP_XOR8>(hi_);
            y[h] = (lane & 8) ? t2_ : t1_;
        }
#pragma unroll
        for (int h = 0; h < 4; ++h) {
            auto sw = __builtin_amdgcn_permlane16_swap(__float_as_uint(y[h]), __float_as_uint(y[h + 4]), false, false);
            y[h] = __uint_as_float(sw[0]) + __uint_as_float(sw[1]);
        }
#pragma unroll
        for (int h = 0; h < 2; ++h) {
            auto sw = __builtin_amdgcn_permlane32_swap(__float_as_uint(y[h]), __float_as_uint(y[h + 2]), false, false);
            y[h] = __uint_as_float(sw[0]) + __uint_as_float(sw[1]);
        }
        *(unsigned*)((bf16_t*)outp + (size_t)t * DM + s * 128 + ci * 16 + 8 * ((lane >> 3) & 1) + 4 * ((lane >> 4) & 1) + 2 * ((lane >> 5) & 1)) = pack2bf(y[0], y[1]);
    }
}
template <bool IS_V>
__device__ void slice_phase(const float* __restrict__ aux, const bf16_t* __restrict__ zbf, const int* __restrict__ idx, const unsigned char* __restrict__ tab8s, float* __restrict__ outp, unsigned* qw, unsigned char* lds) {
    const int tx = opaque_tid();
    const int lane = tx & 63, w = tx >> 6;
    const int g = lane >> 3, ci = lane & 7;
    constexpr int NT = SL_TOKB / 8;
    volatile LAS unsigned* bc = (volatile LAS unsigned*)(lds + LDS_BYTES - 32);
    int s = (int)xb_xcc_id() & 7, tried = 0, tb = 0;
    while (sl_next(qw, s, tried, tb, bc)) {
        const unsigned char* tabs = tab8s + (size_t)s * (16384 * 128);
        const unsigned coff = (unsigned)ci * 16u;
        const int tbase = tb * SL_TOKB + w * NT;
        u32x4 RA[16], RB[16];
        int ia0, ib0, ia1, ib1; float wa0 = 0.f, wb0 = 0.f, wa1 = 0.f, wb1 = 0.f; f32x4 xq0[4], xq1[4];
        SL_META(tbase, ia0, ib0, wa0, wb0, xq0);
        SL_META(tbase + 1, ia1, ib1, wa1, wb1, xq1);
        SL_ISSUE(RA, ia0, ib0);
#pragma unroll 2
        for (int k = 0; k < NT; k += 2) {
            SL_ISSUE(RB, ia1, ib1);
            const float cwa = wa0, cwb = wb0; f32x4 cx[4];
#pragma unroll
            for (int i = 0; i < 4; ++i) cx[i] = xq0[i];
            if (k + 2 < NT) SL_META(tbase + k + 2, ia0, ib0, wa0, wb0, xq0);
            sl_compute<IS_V>(RA, tbase + k, s, lane, g, ci, cwa, cwb, cx, outp);
            if (k + 2 < NT) SL_ISSUE(RA, ia0, ib0);
            const float dwa = wa1, dwb = wb1; f32x4 dx[4];
#pragma unroll
            for (int i = 0; i < 4; ++i) dx[i] = xq1[i];
            if (k + 3 < NT) SL_META(tbase + k + 3, ia1, ib1, wa1, wb1, xq1);
            sl_compute<IS_V>(RB, tbase + k + 1, s, lane, g, ci, dwa, dwb, dx, outp);
        }
    }
}
__device__ void slice_combine_phase(const float* __restrict__ pd, const int* __restrict__ idx, float* __restrict__ gatew, const float* __restrict__ iu, const float* __restrict__ iv,
                                    const float* __restrict__ stats, const float* __restrict__ cu1, const float* __restrict__ cu2, const float* __restrict__ zsc) {
    for (size_t i = (size_t)blockIdx.x * NTHR + threadIdx.x; i < (size_t)T_TOK * 128; i += (size_t)gridDim.x * NTHR) {
        float sacc = 0.f;
#pragma unroll
        for (int s = 0; s < 8; ++s) sacc += bf2f(((const bf16_t*)pd)[(size_t)s * T_TOK * 128 + i]);
        const int id = idx[i];
        const float2 st = *(const float2*)(stats + (i >> 7) * 2);
        gatew[i] = gelu_as(st.y * (sacc * (iu[id] * zsc[i >> 7]) - st.x * cu1[id]) + cu2[id]) * gatew[i] * iv[id];
    }
}
__device__ void ln2_phase(float* __restrict__ x1io, const bf16_t* __restrict__ zbf, const float* __restrict__ ysl, const float* __restrict__ g, const float* __restrict__ bb,
                          const float* __restrict__ stats, const float* __restrict__ g1, const float* __restrict__ b1) {
    const int tx = opaque_tid();
    const int lane = tx & 63;
    const int gw = blockIdx.x * (NTHR / 64) + (tx >> 6);
    const int nw = gridDim.x * (NTHR / 64);
    for (int t = gw; t < T_TOK; t += nw) {
        float* xr = x1io + (size_t)t * DM + 16 * lane;
        const bf16_t* yr = (const bf16_t*)ysl + (size_t)t * DM + 16 * lane;
        float v[16];
        const float2 st = *(const float2*)(stats + (size_t)t * 2);
#pragma unroll
        for (int i = 0; i < 4; ++i) {
            int off1 = 16 * lane + 4 * i;
            asm volatile("" : "+v"(off1));
            const uint2 zp = *(const uint2*)(zbf + (size_t)t * DM + 16 * lane + 4 * i);
            const f32x4 a = {__uint_as_float(zp.x << 16), __uint_as_float(zp.x & 0xffff0000u), __uint_as_float(zp.y << 16), __uint_as_float(zp.y & 0xffff0000u)};
            const uint2 yp = *(const uint2*)(yr + 4 * i);
            const f32x4 y4 = {__uint_as_float(yp.x << 16), __uint_as_float(yp.x & 0xffff0000u), __uint_as_float(yp.y << 16), __uint_as_float(yp.y & 0xffff0000u)};
            const f32x4 g14 = *(const f32x4*)(g1 + off1), b14 = *(const f32x4*)(b1 + off1);
#pragma unroll
            for (int k = 0; k < 4; ++k) v[4 * i + k] = ALPHA * ((a[k] - st.x) * st.y * g14[k] + b14[k]) + y4[k];
        }
        float sm = 0.f;
#pragma unroll
        for (int i = 0; i < 16; ++i) sm += v[i];
        const float mu = wave_sum(sm) * (1.f / 1024.f);
        float qq = 0.f;
#pragma unroll
        for (int i = 0; i < 16; ++i) { const float d = v[i] - mu; qq += d * d; }
        const float rs = __builtin_amdgcn_rsqf(wave_sum(qq) * (1.f / 1024.f) + 1e-5f);
#pragma unroll
        for (int i = 0; i < 4; ++i) {
            int off = 16 * lane + 4 * i;
            asm volatile("" : "+v"(off));
            const f32x4 gv = *(const f32x4*)(g + off), bv = *(const f32x4*)(bb + off);
            f32x4 o;
#pragma unroll
            for (int k = 0; k < 4; ++k) o[k] = (v[4 * i + k] - mu) * rs * gv[k] + bv[k];
            *(f32x4*)(xr + 4 * i) = o;
        }
    }
}

struct Params {
    const float* in[21];
    float* out;
    char* ws;
    int nrep_gather;
    int probe;
};

#define WS_XB      0
#define WS_WIN     64
#define WS_WOUT    70
#define WS_WQ      72
#define WS_SK      76
#define WS_UT      80
#define WS_VT      112
#define WS_H       144
#define WS_X1B     272
#define WS_XC      340
#define WS_ITOP    372
#define WS_IDX     404
#define WS_GATE    420
#define WS_KV      436
#define WS_GAM     500
#define WS_ASEG    501
#define WS_HSEG    503
#define WS_DBG     505
#define WS_BAR     506
#define WS_LRUW    507
#define WS_PSTAT   508
#define WS_END     512
#ifndef DEBUG_HG
#define DEBUG_HG 0
#endif

__global__ void __launch_bounds__(NTHR, 2) mega(Params p) {
    extern __shared__ __attribute__((aligned(16))) unsigned char lds[];
    if (threadIdx.x < 4) ((volatile LAS unsigned*)(lds + LDS_BYTES - 16))[threadIdx.x] = 0u;
    __syncthreads();
    const XcdBarrier gbar = xcd_barrier_post((unsigned*)(p.ws + (size_t)WS_BAR * 1024 * 1024), (volatile LAS unsigned*)(lds + LDS_BYTES - 16));
    const float* x = p.in[0];
    const float* w_in = p.in[1];
    const float* conv_w = p.in[2];
    const float* conv_b = p.in[3];
    const float* lru_wa = p.in[4];
    const float* lru_ba = p.in[5];
    const float* lru_wx = p.in[6];
    const float* lru_bx = p.in[7];
    const float* lru_lam = p.in[8];
    const float* lru_ng = p.in[9];
    const float* lbl = p.in[10];
    const float* hg_ng = p.in[11];
    const float* w_out = p.in[12];
    const float* ln1_g = p.in[13];
    const float* ln1_b = p.in[14];
    const float* wq = p.in[15];
    const float* subk = p.in[16];
    const float* ut = p.in[17];
    const float* vt = p.in[18];
    const float* ln2_g = p.in[19];
    const float* ln2_b = p.in[20];
    float* out = p.out;
    char* ws = p.ws;
    const size_t MB = 1024 * 1024;
    bf16_t* xb = (bf16_t*)(ws + WS_XB * MB);
    bf16_t* mixin = (bf16_t*)(ws + WS_XB * MB);
    bf16_t* w_inT = (bf16_t*)(ws + WS_WIN * MB);
    bf16_t* w_outT = (bf16_t*)(ws + WS_WOUT * MB);
    bf16_t* wqT = (bf16_t*)(ws + WS_WQ * MB);
    bf16_t* utb = (bf16_t*)(ws + WS_UT * MB);
    bf16_t* skb = (bf16_t*)(ws + WS_SK * MB);
    unsigned char* u8 = (unsigned char*)(ws + WS_UT * MB);
    unsigned char* v8 = (unsigned char*)(ws + WS_VT * MB);
    float* iu = (float*)(ws + (WS_UT + 16) * MB);
    float* iv = (float*)(ws + (WS_VT + 16) * MB);
    float* cu1 = iu + 16384;
    float* cu2 = iu + 2 * 16384;
    float* qc1 = (float*)(ws + 77 * MB);
    float* qc2 = qc1 + 2048;
    float* stats = (float*)(ws + 77 * MB + 65536);
    float* qc1p = (float*)(ws + 78 * MB);
    float* qc2p = qc1p + 16 * 2048;
    float* pstat = (float*)(ws + (size_t)WS_PSTAT * MB);
    unsigned char* zq = (unsigned char*)(ws + (size_t)WS_XC * MB);
    float* zsc = (float*)(ws + (size_t)(WS_XC + 32) * MB);
    bf16_t* vtb = (bf16_t*)(ws + WS_VT * MB);
    bf16_t* h = (bf16_t*)(ws + WS_H * MB);
    float* z = (float*)(ws + WS_H * MB);
    bf16_t* q = (bf16_t*)(ws + WS_H * MB);
    bf16_t* x1b = (bf16_t*)(ws + WS_X1B * MB);
    float* xc = (float*)(ws + WS_XC * MB);
    float* s_top = (float*)(ws + WS_XC * MB);
    int* i_top = (int*)(ws + WS_ITOP * MB);
    int* idx = (int*)(ws + WS_IDX * MB);
    float* gate = (float*)(ws + WS_GATE * MB);
    bf16_t* kvb = (bf16_t*)(ws + WS_KV * MB);
    float* gam = (float*)(ws + WS_GAM * MB);
    float* dbg = (float*)(ws + WS_DBG * MB);
    float* aseg = (float*)(ws + WS_ASEG * MB);
    float* hseg = (float*)(ws + WS_HSEG * MB);
    bf16_t* lruwT = (bf16_t*)(ws + WS_LRUW * MB);
    bf16_t* mixin2 = (bf16_t*)(ws + WS_XC * MB);
    float* a_arr = out;
    float* u_arr = out + (size_t)T_TOK * 512;
    const int G = gridDim.x, bid = blockIdx.x;
    const int half = threadIdx.x >> 8, tid = threadIdx.x & 255;
    float* smf = (float*)lds;
    if (bid == 0 && threadIdx.x == 0) { dbg[0] = 0.f; dbg[1] = 0.f; }

#define REPEAT(k) _Pragma("unroll 1") for (int rp_ = (p.probe == (k) || ((k) == 4 && p.probe == 9)) ? 1 : 0; rp_ >= 0; --rp_)
    REPEAT(1) {
    for (int u = bid; u < T_TOK * DM / 4096; u += G) cvt_unit(u, x, xb);
    for (int u = bid; u < 64; u += G) cvt_unit(u, subk, skb);
    for (int e = bid * NTHR + threadIdx.x; e < 2 * 8 * 64 * 64; e += G * NTHR) {
        const int i_ = e & 63, j_ = (e >> 6) & 63, hh_ = (e >> 12) & 7, g_ = e >> 15;
        lruwT[e] = f2bf(-1.4426950408889634f * (g_ ? lru_wx : lru_wa)[(hh_ * 64 + i_) * 64 + j_]);
    }
    for (int u = bid; u < 16 * 48 + 16 * 16 + 16 * 32; u += G) {
        if (u < 768) transpose_unit(u, w_in, w_inT, 1024, 3072, smf);
        else if (u < 768 + 256) transpose_unit(u - 768, w_out, w_outT, 1024, 1024, smf);
        else transpose_unit(u - 1024, wq, wqT, 1024, 2048, smf, ln1_g, ln1_b, qc1p, qc2p);
    }
    }
    xcd_barrier(gbar);
    REPEAT(2) {
        pg8::Gemm g{xb, w_inT, T_TOK, INW, DM}; pg8::StaticOrder S; S.init(T_TOK, INW, G, bid);
        EpiBf16 E{h, INW};
        pg8::gemm_phase<EpiBf16, pg8::StaticOrder, false>((PG8_LAS unsigned char*)lds, g, S, E, nullptr);
    }
    xcd_barrier(gbar);
    {
        lru2_units<false>(bid, G, h, conv_w, conv_b, lruwT, lru_ba, lru_bx, lru_lam, lru_ng, aseg, hseg, mixin, lds);
        if (bid < 2048) {
            float lb4[2][4];
            { const int d_ = 2 * (opaque_tid() & 63);
#pragma unroll
              for (int k = 0; k < 4; ++k) { lb4[0][k] = hg_lb(lbl, k * 128 + d_); lb4[1][k] = hg_lb(lbl, k * 128 + d_ + 1); } }
            HgP2Regs cur, nxt;
            hgrn_p2_load(bid, h, cur);
#pragma unroll 1
            for (int u = bid; u < 2048; u += G) {
                if (!PF_HG2 && u != bid) hgrn_p2_load(u, h, cur);
                if (PF_HG2 && u + G < 2048) hgrn_p2_load(u + G, h, nxt);
                hgrn_p2_body(u, cur, lb4, kvb, gam, lds);
                if (PF_HG2) cur = nxt;
            }
        }
    }
    xcd_barrier(gbar);
    if (threadIdx.x < 256) {
        hgrn_scan4(threadIdx.x, kvb, gam);
        if (bid < 8) lru2_carry(bid, threadIdx.x, aseg, hseg);
    } else {
        for (int r = bid * 4 + ((threadIdx.x - 256) >> 6); r < 2 * 16384; r += G * 4) {
            if (r < 16384) quant_row(ut, u8, iu, r, threadIdx.x & 63, ln1_g, ln1_b, cu1, cu2, true); else quant_row(vt, v8, iv, r - 16384, threadIdx.x & 63);
        }
    }
    xcd_barrier(gbar);
    {
        lru2_units<true>(bid, G, h, conv_w, conv_b, lruwT, lru_ba, lru_bx, lru_lam, lru_ng, aseg, hseg, mixin, lds);
        if (bid < 2048) {
            float lb4[2][4], gn4[4];
            { const int d_ = 2 * (opaque_tid() & 63), e_ = (opaque_tid() & 31) + 32 * ((opaque_tid() >> 6) & 3);
#pragma unroll
              for (int k = 0; k < 4; ++k) { lb4[0][k] = hg_lb(lbl, k * 128 + d_); lb4[1][k] = hg_lb(lbl, k * 128 + d_ + 1); gn4[k] = hg_ng[k * 128 + e_]; } }
            HgP4Regs cur, nxt;
            hgrn_p4_load(bid, h, kvb, cur);
#pragma unroll 1
            for (int u = bid; u < 2048; u += G) {
                if (!PF_HG4 && u != bid) hgrn_p4_load(u, h, kvb, cur);
                if (PF_HG4 && u + G < 2048) hgrn_p4_load(u + G, h, kvb, nxt);
                hgrn_p4_body(u, cur, lb4, gn4, mixin, lds);
                if (PF_HG4) cur = nxt;
            }
        }
    }
    xcd_barrier(gbar);
    REPEAT(5) {
        pg8::Gemm g{mixin, w_outT, T_TOK, DM, DM}; pg8::StaticOrder S; S.init(T_TOK, DM, G, bid);
        EpiZ E{x1b, x, pstat, ALPHA};
        pg8::gemm_phase<EpiZ, pg8::StaticOrder, false>((PG8_LAS unsigned char*)lds, g, S, E, nullptr);
    }
    xcd_barrier(gbar);
    for (int n = bid * NTHR + threadIdx.x; n < 2048; n += G * NTHR) {
        float s1 = 0.f, s2 = 0.f;
#pragma unroll
        for (int kt = 0; kt < 16; ++kt) { s1 += qc1p[kt * 2048 + n]; s2 += qc2p[kt * 2048 + n]; }
        qc1[n] = s1; qc2[n] = s2;
    }
    for (int t = bid * (NTHR / 64) + (threadIdx.x >> 6); t < T_TOK; t += G * (NTHR / 64)) {
        const int ln = threadIdx.x & 63;
        const u32x4* zp = (const u32x4*)(x1b + (size_t)t * DM + 16 * ln);
        const u32x4 z0 = zp[0], z1 = zp[1];
        const unsigned zw[8] = {z0.x, z0.y, z0.z, z0.w, z1.x, z1.y, z1.z, z1.w};
        float zf[16]; float m = 0.f;
#pragma unroll
        for (int k = 0; k < 8; ++k) { zf[2 * k] = __uint_as_float(zw[k] << 16); zf[2 * k + 1] = __uint_as_float(zw[k] & 0xffff0000u); m = fmaxf(m, fmaxf(fabsf(zf[2 * k]), fabsf(zf[2 * k + 1]))); }
#pragma unroll
        for (int o = 32; o > 0; o >>= 1) m = fmaxf(m, __shfl_xor(m, o));
        const float sc = m > 0.f ? 127.f / m : 1.f;
        u32x4 wq4;
#pragma unroll
        for (int k = 0; k < 4; ++k) wq4[k] = pack_i8x4(zf[4 * k] * sc, zf[4 * k + 1] * sc, zf[4 * k + 2] * sc, zf[4 * k + 3] * sc);
        *(u32x4*)(zq + (size_t)t * DM + 16 * ln) = wq4;
        if (ln == 0) zsc[t] = m > 0.f ? m / 127.f : 1.f;
    }
    for (int t = bid * NTHR + threadIdx.x; t < T_TOK; t += G * NTHR) {
        const f32x4* pp = (const f32x4*)(pstat + (size_t)t * 32);
        float s1 = 0.f, s2 = 0.f;
#pragma unroll
        for (int i = 0; i < 8; ++i) { const f32x4 v = pp[i]; s1 += v[0] + v[2]; s2 += v[1] + v[3]; }
        const float mu = s1 * (1.f / 1024.f);
        float2 st; st.x = mu; st.y = __builtin_amdgcn_rsqf(fmaxf(s2 * (1.f / 1024.f) - mu * mu, 0.f) + 1e-5f);
        *(float2*)(stats + (size_t)t * 2) = st;
    }
    xcd_barrier(gbar);
    REPEAT(7) {
        pg8::Gemm g{x1b, wqT, T_TOK, 2048, DM}; pg8::StaticOrder S; S.init(T_TOK, 2048, G, bid);
        EpiQ E{q, 2048, stats, qc1, qc2};
        pg8::gemm_phase<EpiQ, pg8::StaticOrder, false>((PG8_LAS unsigned char*)lds, g, S, E, nullptr);
    }
    xcd_barrier(gbar);
    REPEAT(8) topk_phase(q, skb, idx, gate, lds);
    xcd_barrier(gbar);
#if PEER_SLICED
    {
        unsigned* qw = (unsigned*)(p.ws + (size_t)WS_BAR * 1024 * 1024) + XCD_BAR_WORDS;
        float* pd = (float*)(ws + WS_H * MB);
        slice_phase<false>(nullptr, (const bf16_t*)zq, idx, u8, pd, qw, lds);
        xcd_barrier(gbar);
        slice_combine_phase(pd, idx, gate, iu, iv, stats, cu1, cu2, zsc);
        xcd_barrier(gbar);
        slice_phase<true>(gate, nullptr, idx, v8, pd, qw + 8, lds);
        xcd_barrier(gbar);
        ln2_phase(out, x1b, pd, ln2_g, ln2_b, stats, ln1_g, ln1_b);
    }
#else
#pragma unroll 1
    for (int rp = p.nrep_gather; rp >= 0; --rp)
        gather8_phase(out, rp ? (float*)(ws + WS_H * MB) : out, idx, gate, u8, v8, iu, iv, ln2_g, ln2_b);
#endif
}

extern "C" void kernel_launch(void* const* d_in, const int* in_sizes, int n_in, void* d_out, int out_size, void* d_ws, size_t ws_size, hipStream_t stream) {
    static int grid_blocks = 0;
    if (!grid_blocks) {
        int dev = 0, cus = 0, per_cu = 0;
        (void)hipGetDevice(&dev);
        (void)hipDeviceGetAttribute(&cus, hipDeviceAttributeMultiprocessorCount, dev);
        if (hipFuncSetAttribute((const void*)mega, hipFuncAttributeMaxDynamicSharedMemorySize, LDS_BYTES) != hipSuccess) { fprintf(stderr, "hipFuncSetAttribute failed\n"); return; }
        (void)hipOccupancyMaxActiveBlocksPerMultiprocessor(&per_cu, mega, NTHR, LDS_BYTES);
        if (per_cu < 1) { fprintf(stderr, "occupancy query says %d\n", per_cu); return; }
        grid_blocks = cus;
    }
    if (ws_size < (size_t)WS_END * 1024 * 1024 || n_in != 21) { fprintf(stderr, "ws too small %zu or n_in %d\n", ws_size, n_in); return; }
    Params p{};
    for (int i = 0; i < 21; i++) p.in[i] = (const float*)d_in[i];
    p.out = (float*)d_out;
    p.ws = (char*)d_ws;
    p.nrep_gather = PROBE_NREP;
    p.probe = PROBE_PHASE;
    if (hipMemsetAsync((char*)d_ws + (size_t)WS_BAR * 1024 * 1024, 0, (XCD_BAR_WORDS + 16) * 4, stream) != hipSuccess) { fprintf(stderr, "memset of barrier words failed\n"); return; }
    void* args[] = {&p};
    hipError_t e = hipLaunchCooperativeKernel((void*)mega, dim3(grid_blocks), dim3(NTHR), args, LDS_BYTES, stream);
    if (e != hipSuccess) fprintf(stderr, "cooperative launch failed: %s (grid %d)\n", hipGetErrorString(e), grid_blocks);
}
```
